# Optimizing an MI355X kernel written in HIP

```python
import jax, jax.numpy as jnp
from jax import lax
import numpy as np

D_MODEL = 1024
BATCH = 32
SEQ = 2048
DEPTH = 1

HEAD_DIM = 64
DIL_CONFIGS = ((128, 1), (512, 4), (2048, 16))
N_DIL_GROUPS = 3
DIL_HEADS = 4
DIL_WIDTH = N_DIL_GROUPS * DIL_HEADS * HEAD_DIM
DIL_OUT_WIDTH = DIL_HEADS * HEAD_DIM
GQA_Q_HEADS = 16
GQA_KV_HEADS = 4
GQA_REP = GQA_Q_HEADS // GQA_KV_HEADS
GQA_Q_WIDTH = GQA_Q_HEADS * HEAD_DIM
GQA_KV_WIDTH = GQA_KV_HEADS * HEAD_DIM
N_BRANCHES = 2
IN_WIDTH = 3 * DIL_WIDTH + GQA_Q_WIDTH + 2 * GQA_KV_WIDTH + N_BRANCHES * D_MODEL
QBLK = 128
GRID_W = 64
ROPE_THETA = 10000.0
N_EXPERTS = 256
TOP_K = 8
N_EXPERT_GROUPS = 8
TOPK_GROUPS = 4
EXPERT_FF = 256
SHARED_FF = 256
ROUTED_SCALE = 2.5
MOE_BLOCK = 128
NORM_EPS = 1e-6

kernel_name = "hybrid_dilated_gqa_moe_adaln_block"


def rms_norm(x, g):
    xf = x.astype(jnp.float32)
    y = xf * lax.rsqrt(jnp.mean(xf * xf, axis=-1, keepdims=True) + NORM_EPS)
    return (y * g.astype(jnp.float32)).astype(x.dtype)


def rope_cos_sin(pos, dim):
    inv = ROPE_THETA ** (-jnp.arange(0, dim, 2, dtype=jnp.float32) / dim)
    ang = pos.astype(jnp.float32)[:, None] * inv[None, :]
    ang = jnp.concatenate([ang, ang], axis=-1)
    return jnp.cos(ang), jnp.sin(ang)


def apply_rope(x, cos, sin):
    xf = x.astype(jnp.float32)
    x1, x2 = jnp.split(xf, 2, axis=-1)
    rot = jnp.concatenate([-x2, x1], axis=-1)
    extra = x.ndim - 3
    shp = (1, cos.shape[0]) + (1,) * extra + (cos.shape[1],)
    return (xf * cos.reshape(shp) + rot * sin.reshape(shp)).astype(x.dtype)


def dilated_window_attention(q, k, v, dil, n):
    B, S, H, hd = q.shape
    L = S // dil
    nb = -(-L // n)
    Lp = nb * n

    def to_res(a):
        a = a.reshape(B, L, dil, H, hd).transpose(0, 2, 1, 3, 4)
        return jnp.pad(a, ((0, 0), (0, 0), (0, Lp - L), (0, 0), (0, 0)))

    def band(a):
        ap = jnp.pad(a, ((0, 0), (0, 0), (n, n), (0, 0), (0, 0)))
        parts = [ap[:, :, i * n: i * n + Lp].reshape(B, dil, nb, n, H, hd) for i in range(3)]
        return jnp.concatenate(parts, axis=3)

    qb = to_res(q).reshape(B, dil, nb, n, H, hd)
    kb = band(to_res(k))
    vb = band(to_res(v))
    s = jnp.einsum('brnqhd,brnkhd->brnhqk', qb, kb).astype(jnp.float32) * (hd ** -0.5)
    blk = jnp.arange(nb)[:, None]
    q_pos = blk * n + jnp.arange(n)[None, :]
    k_pos = blk * n - n + jnp.arange(3 * n)[None, :]
    diff = k_pos[:, None, :] - q_pos[:, :, None]
    valid = (jnp.abs(diff) <= n) & (k_pos[:, None, :] >= 0) & (k_pos[:, None, :] < L)
    s = jnp.where(valid[None, None, :, None, :, :], s, -jnp.inf)
    lse = jax.nn.logsumexp(s, axis=-1)
    p = jnp.exp(s - lse[..., None])
    o = jnp.einsum('brnhqk,brnkhd->brnqhd', p.astype(v.dtype), vb)
    o = o.reshape(B, dil, Lp, H, hd)[:, :, :L].transpose(0, 2, 1, 3, 4).reshape(B, S, H, hd)
    lse = lse.transpose(0, 1, 2, 4, 3).reshape(B, dil, Lp, H)[:, :, :L]
    lse = lse.transpose(0, 2, 1, 3).reshape(B, S, H)
    return o, lse


def dilated_mixture(q, k, v):
    outs, lses = [], []
    for g, (window, dil) in enumerate(DIL_CONFIGS):
        o, lse = dilated_window_attention(q[:, :, g], k[:, :, g], v[:, :, g], dil, window // (2 * dil))
        outs.append(o)
        lses.append(lse)
    w = jax.nn.softmax(jnp.stack(lses, axis=0), axis=0)
    o = jnp.sum(w[..., None] * jnp.stack(outs, axis=0).astype(jnp.float32), axis=0)
    B, S = q.shape[:2]
    return o.astype(q.dtype).reshape(B, S, DIL_OUT_WIDTH)


def gqa_blocked(q, k, v):
    B, S, _, hd = q.shape
    nqb = S // QBLK
    qb = q.reshape(B, nqb, QBLK, GQA_KV_HEADS, GQA_REP, hd).transpose(1, 0, 2, 3, 4, 5)

    def one_block(qblk):
        s = jnp.einsum('bqgrd,bkgd->bgrqk', qblk, k).astype(jnp.float32) * (hd ** -0.5)
        p = jax.nn.softmax(s, axis=-1)
        return jnp.einsum('bgrqk,bkgd->bqgrd', p.astype(v.dtype), v)

    o = lax.map(one_block, qb)
    return o.transpose(1, 0, 2, 3, 4, 5).reshape(B, S, GQA_Q_WIDTH)


def swiglu(h, w_gate, w_up, w_down):
    return (jax.nn.silu(h @ w_gate) * (h @ w_up)) @ w_down


def routed_moe(h, router_w, router_bias, w_exp_gate, w_exp_up, w_exp_down):
    T, D = h.shape
    E = N_EXPERTS
    scores = jax.nn.sigmoid((h @ router_w).astype(jnp.float32))
    biased = scores + router_bias.astype(jnp.float32)[None, :]
    grp = biased.reshape(T, N_EXPERT_GROUPS, E // N_EXPERT_GROUPS)
    grp_score = lax.top_k(grp, 2)[0].sum(-1)
    _, grp_idx = lax.top_k(grp_score, TOPK_GROUPS)
    grp_mask = jax.nn.one_hot(grp_idx, N_EXPERT_GROUPS, dtype=jnp.float32).sum(1)
    exp_mask = jnp.repeat(grp_mask, E // N_EXPERT_GROUPS, axis=1)
    _, idx = lax.top_k(jnp.where(exp_mask > 0, biased, -jnp.inf), TOP_K)
    gate = jnp.take_along_axis(scores, idx, axis=1)
    gate = gate / jnp.sum(gate, axis=-1, keepdims=True) * ROUTED_SCALE

    A = T * TOP_K
    flat_e = idx.reshape(-1).astype(jnp.int32)
    order = jnp.argsort(flat_e)
    sorted_e = flat_e[order]
    tok_sorted = (order // TOP_K).astype(jnp.int32)
    gate_sorted = gate.reshape(-1)[order].astype(h.dtype)
    counts = jnp.bincount(flat_e, length=E).astype(jnp.int32)
    start = jnp.cumsum(counts) - counts
    padded = ((counts + MOE_BLOCK - 1) // MOE_BLOCK) * MOE_BLOCK
    pend = jnp.cumsum(padded)
    pstart = pend - padded
    dest = pstart[sorted_e] + (jnp.arange(A, dtype=jnp.int32) - start[sorted_e])
    NB = -(-A // MOE_BLOCK) + E
    buf_tok = jnp.full((NB * MOE_BLOCK,), T, dtype=jnp.int32).at[dest].set(tok_sorted)
    buf_gate = jnp.zeros((NB * MOE_BLOCK,), dtype=h.dtype).at[dest].set(gate_sorted)
    block_expert = jnp.searchsorted(pend, jnp.arange(NB, dtype=jnp.int32) * MOE_BLOCK, side='right')
    block_expert = jnp.minimum(block_expert, E - 1).astype(jnp.int32)
    h_pad = jnp.concatenate([h, jnp.zeros((1, D), h.dtype)], axis=0)

    def step(acc, blk):
        e, tok, g = blk
        rows = h_pad[tok]
        y = swiglu(rows, w_exp_gate[e], w_exp_up[e], w_exp_down[e])
        return acc.at[tok].add(y * g[:, None]), None

    acc0 = jnp.zeros((T + 1, D), h.dtype)
    acc, _ = lax.scan(step, acc0, (block_expert,
                                   buf_tok.reshape(NB, MOE_BLOCK),
                                   buf_gate.reshape(NB, MOE_BLOCK)))
    return acc[:T]


def setup_inputs(seed: int = 0) -> dict:
    key = jax.random.key(seed)
    ks = jax.random.split(key, 22)
    D = D_MODEL
    nrm = lambda k, shp, s: jax.random.normal(k, shp, jnp.float32) * s
    return {
        "x": nrm(ks[0], (BATCH, SEQ, D), 1.0),
        "c": nrm(ks[1], (BATCH, D), 1.0),
        "w_ada": nrm(ks[2], (D, 6 * D), 0.5 * D ** -0.5),
        "b_ada": nrm(ks[3], (6 * D,), 0.01),
        "norm1_g": 1.0 + nrm(ks[4], (D,), 0.02),
        "w_in": nrm(ks[5], (D, IN_WIDTH), D ** -0.5),
        "b_gate": nrm(ks[6], (N_BRANCHES * D,), 0.01),
        "qn_g": 1.0 + nrm(ks[7], (HEAD_DIM,), 0.02),
        "kn_g": 1.0 + nrm(ks[8], (HEAD_DIM,), 0.02),
        "w_o_dil": nrm(ks[9], (DIL_OUT_WIDTH, D), DIL_OUT_WIDTH ** -0.5),
        "w_o_gqa": nrm(ks[10], (GQA_Q_WIDTH, D), GQA_Q_WIDTH ** -0.5),
        "w_out": nrm(ks[11], (D, D), D ** -0.5),
        "norm2_g": 1.0 + nrm(ks[12], (D,), 0.02),
        "router_w": nrm(ks[13], (D, N_EXPERTS), D ** -0.5),
        "router_bias": nrm(ks[14], (N_EXPERTS,), 0.01),
        "w_exp_gate": nrm(ks[15], (N_EXPERTS, D, EXPERT_FF), D ** -0.5),
        "w_exp_up": nrm(ks[16], (N_EXPERTS, D, EXPERT_FF), D ** -0.5),
        "w_exp_down": nrm(ks[17], (N_EXPERTS, EXPERT_FF, D), EXPERT_FF ** -0.5),
        "w_sh_gate": nrm(ks[18], (D, SHARED_FF), D ** -0.5),
        "w_sh_up": nrm(ks[19], (D, SHARED_FF), D ** -0.5),
        "w_sh_down": nrm(ks[20], (SHARED_FF, D), SHARED_FF ** -0.5),
        "final_g": 1.0 + nrm(ks[21], (D,), 0.02),
    }


def reference(x, c, w_ada, b_ada, norm1_g, w_in, b_gate, qn_g, kn_g, w_o_dil, w_o_gqa,
              w_out, norm2_g, router_w, router_bias, w_exp_gate, w_exp_up, w_exp_down,
              w_sh_gate, w_sh_up, w_sh_down, final_g):
    B, S, D = x.shape
    hd = HEAD_DIM
    rows = S // GRID_W
    t = jnp.arange(S, dtype=jnp.int32)
    cos1, sin1 = rope_cos_sin(t, hd)
    row_pos = jnp.repeat(jnp.arange(rows, dtype=jnp.int32), GRID_W)
    col_pos = jnp.tile(jnp.arange(GRID_W, dtype=jnp.int32), rows)
    cos_r, sin_r = rope_cos_sin(row_pos, hd // 2)
    cos_c, sin_c = rope_cos_sin(col_pos, hd // 2)

    for _ in range(DEPTH):
        mod = (jax.nn.silu(c) @ w_ada + b_ada).reshape(B, 6, D)
        shift1, scale1, gate1, shift2, scale2, gate2 = [mod[:, i][:, None, :] for i in range(6)]

        h = rms_norm(x, norm1_g) * (1.0 + scale1) + shift1
        proj = h @ w_in
        o0 = 0
        qa = proj[..., o0:o0 + DIL_WIDTH]; o0 += DIL_WIDTH
        ka = proj[..., o0:o0 + DIL_WIDTH]; o0 += DIL_WIDTH
        va = proj[..., o0:o0 + DIL_WIDTH]; o0 += DIL_WIDTH
        qb = proj[..., o0:o0 + GQA_Q_WIDTH]; o0 += GQA_Q_WIDTH
        kb = proj[..., o0:o0 + GQA_KV_WIDTH]; o0 += GQA_KV_WIDTH
        vb = proj[..., o0:o0 + GQA_KV_WIDTH]; o0 += GQA_KV_WIDTH
        gates = jax.nn.sigmoid(proj[..., o0:o0 + N_BRANCHES * D] + b_gate)
        g_a, g_b = gates[..., :D], gates[..., D:]

        dshape = (B, S, N_DIL_GROUPS, DIL_HEADS, hd)
        qa = apply_rope(qa.reshape(dshape), cos1, sin1)
        ka = apply_rope(ka.reshape(dshape), cos1, sin1)
        va = va.reshape(dshape)
        y_a = dilated_mixture(qa, ka, va) @ w_o_dil

        qb = rms_norm(qb.reshape(B, S, GQA_Q_HEADS, hd), qn_g)
        kb = rms_norm(kb.reshape(B, S, GQA_KV_HEADS, hd), kn_g)
        vb = vb.reshape(B, S, GQA_KV_HEADS, hd)
        half = hd // 2
        qb = jnp.concatenate([apply_rope(qb[..., :half], cos_r, sin_r),
                              apply_rope(qb[..., half:], cos_c, sin_c)], axis=-1)
        kb = jnp.concatenate([apply_rope(kb[..., :half], cos_r, sin_r),
                              apply_rope(kb[..., half:], cos_c, sin_c)], axis=-1)
        y_b = gqa_blocked(qb, kb, vb) @ w_o_gqa

        mixed = (g_a * y_a + g_b * y_b) @ w_out
        x = x + gate1 * mixed

        h2 = (rms_norm(x, norm2_g) * (1.0 + scale2) + shift2).reshape(B * S, D)
        ffn = swiglu(h2, w_sh_gate, w_sh_up, w_sh_down) + routed_moe(
            h2, router_w, router_bias, w_exp_gate, w_exp_up, w_exp_down)
        x = x + gate2 * ffn.reshape(B, S, D)

    return rms_norm(x, final_g)
```

```cpp
#include <hip/hip_runtime.h>
#include <cstdio>
#include <cstdint>
#include <cmath>

constexpr int NB = 32, SEQ = 2048, DM = 1024, NT = NB * SEQ;
constexpr int HD = 64;
constexpr int DILW = 768, GQW = 1024, GKW = 256, INW = 5888;
constexpr int C_QA = 0, C_KA = 768, C_VA = 1536, C_QB = 2304, C_KB = 3328, C_VB = 3584, C_GT = 3840;
constexpr int NEXP = 256, TOPK = 8, EFF = 256;
constexpr float NORM_EPS = 1e-6f;
constexpr float QSCALE = 0.125f * 1.4426950408889634f;
constexpr int NCHUNK = 1, CH_TOK = NT / NCHUNK;
constexpr int CH_SLOTS = CH_TOK * TOPK + NEXP * 256;

constexpr size_t MiB = 1u << 20;
constexpr size_t WS_CTL = 0;
constexpr size_t WS_MOD = 1 * MiB;
constexpr size_t WS_ROPE = 2 * MiB;
constexpr size_t WS_MISC = 3 * MiB;
constexpr size_t WS_RT = 4 * MiB;
constexpr size_t WS_IDX = WS_RT;
constexpr size_t WS_GATEV = WS_RT + 2 * MiB;
constexpr size_t WS_POSE = WS_RT + 4 * MiB;
constexpr size_t WS_STOK = WS_RT + 6 * MiB;
constexpr size_t WS_SGATE = WS_RT + 9 * MiB;
constexpr size_t WS_A = 16 * MiB;
constexpr size_t WS_QA = WS_A, WS_KA = WS_QA + 96 * MiB, WS_VA = WS_KA + 96 * MiB, WS_QB = WS_VA + 96 * MiB, WS_KB = WS_QB + 128 * MiB, WS_VB = WS_KB + 32 * MiB,
                 WS_GATES = WS_VB + 32 * MiB, WS_ATT = WS_GATES + 256 * MiB, WS_P1END = WS_ATT + 160 * MiB;
constexpr size_t WS_GATED = WS_A;
constexpr size_t WS_H2 = WS_A;
constexpr size_t WS_LOGITS = 560 * MiB;
constexpr size_t WS_SHACT = 624 * MiB;
constexpr size_t WS_ACT = 656 * MiB;
constexpr size_t WS_NEED = 1084 * MiB;
constexpr int CW_COUNTS = 1024;
constexpr int MW_PSTART = 0, MW_PEND = 512, MW_CNT = 1024;

typedef unsigned short bf16;
__device__ __forceinline__ float bf2f(bf16 b) { return __uint_as_float(((unsigned)b) << 16); }
__device__ __forceinline__ bf16 f2bf(float f) { unsigned u = __float_as_uint(f); return (bf16)((u + 0x7fffu + ((u >> 16) & 1u)) >> 16); }
__device__ __forceinline__ float wave_sum(float v) {
#pragma unroll
    for (int o = 1; o < 64; o <<= 1) v += __shfl_xor(v, o);
    return v;
}
__device__ __forceinline__ float sigmoidf_(float x) { return 1.f / (1.f + __expf(-x)); }

__global__ void k_mod(const float* c, const float* w_ada, const float* b_ada, float* mod) {
    const int idx = blockIdx.x * 256 + threadIdx.x; const int b = idx / 6144, j = idx % 6144;
    float acc = 0.f;
    for (int k = 0; k < DM; ++k) { const float cv = c[b * DM + k]; acc += (cv / (1.f + __expf(-cv))) * w_ada[(size_t)k * 6144 + j]; }
    mod[idx] = acc + b_ada[j];
}
__global__ void k_tables(float* rope) {
    float* C1 = rope; float* S1 = rope + 65536; float* CR = rope + 131072; float* SR = CR + 512; float* CC = SR + 512; float* SC = CC + 1024;
    const int idx = blockIdx.x * 256 + threadIdx.x;
    if (idx < 65536) { const int t = idx >> 5, j = idx & 31; const double a = (double)t * pow(10000.0, -(double)j / 32.0); C1[idx] = (float)cos(a); S1[idx] = (float)sin(a); }
    if (idx < 512) { const int p = idx >> 4, j = idx & 15; const double a = (double)p * pow(10000.0, -(double)j / 16.0); CR[idx] = (float)cos(a); SR[idx] = (float)sin(a); }
    if (idx < 1024) { const int p = idx >> 4, j = idx & 15; const double a = (double)p * pow(10000.0, -(double)j / 16.0); CC[idx] = (float)cos(a); SC[idx] = (float)sin(a); }
}
__global__ void k_norm_rows(const float* x, const float* g, const float* mod, int i_shift, int i_scale, bf16* out) {
    const int row = blockIdx.x * 4 + (threadIdx.x >> 6), lane = threadIdx.x & 63; const int b = row / SEQ;
    const float* xr = x + (size_t)row * DM; float v[16]; float ss = 0.f;
#pragma unroll
    for (int j = 0; j < 16; ++j) { v[j] = xr[lane + 64 * j]; ss += v[j] * v[j]; }
    const float rstd = 1.f / sqrtf(wave_sum(ss) * (1.f / DM) + NORM_EPS);
    const float* sh = mod + (size_t)b * 6144 + i_shift * DM; const float* sc = mod + (size_t)b * 6144 + i_scale * DM;
#pragma unroll
    for (int j = 0; j < 16; ++j) { const int cidx = lane + 64 * j; out[(size_t)row * DM + cidx] = f2bf(v[j] * rstd * g[cidx] * (1.f + sc[cidx]) + sh[cidx]); }
}
__global__ void k_final(float* xo, const float* g) {
    const int row = blockIdx.x * 4 + (threadIdx.x >> 6), lane = threadIdx.x & 63;
    float* xr = xo + (size_t)row * DM; float v[16]; float ss = 0.f;
#pragma unroll
    for (int j = 0; j < 16; ++j) { v[j] = xr[lane + 64 * j]; ss += v[j] * v[j]; }
    const float rstd = 1.f / sqrtf(wave_sum(ss) * (1.f / DM) + NORM_EPS);
#pragma unroll
    for (int j = 0; j < 16; ++j) { const int cidx = lane + 64 * j; xr[cidx] = v[j] * rstd * g[cidx]; }
}

struct RouteTabs { const int* stok; const float* sgate; const int* pstart; const int* pend; const int* cnt; };
__device__ __forceinline__ int expert_of_slot(const RouteTabs& R, int slot, int& chunk, int& local) {
    chunk = slot / CH_SLOTS; local = slot - chunk * CH_SLOTS; const int* pe = R.pend + chunk * NEXP;
    int lo = 0, hi = NEXP;
    while (lo < hi) { const int mid = (lo + hi) >> 1; if (pe[mid] > local) hi = mid; else lo = mid + 1; }
    return lo;
}
struct AlPlain { const bf16* A; int lda; int pad;
    __device__ int group(int rt) const { return 0; }
    __device__ float load(int grp, int rt, int r, int k) const { return bf2f(A[(size_t)(rt * 64 + r) * lda + k]); } };
struct AlGather { const bf16* A; RouteTabs R; int lda; int pad;
    __device__ int group(int rt) const { int ch, loc; const int e = expert_of_slot(R, rt * 64, ch, loc); if (e >= NEXP) return -1;
        const int n = R.cnt[ch * NEXP + e]; if (loc - R.pstart[ch * NEXP + e] >= n) return -1; return e; }
    __device__ float load(int grp, int rt, int r, int k) const { const int tok = R.stok[rt * 64 + r] >> 3; return tok < 0 ? 0.f : bf2f(A[(size_t)tok * lda + k]); } };
struct AlSlot { const bf16* A; RouteTabs R;
    __device__ int group(int rt) const { int ch, loc; const int e = expert_of_slot(R, rt * 64, ch, loc); if (e >= NEXP) return -1; const int n = R.cnt[ch * NEXP + e]; if (loc - R.pstart[ch * NEXP + e] >= n) return -1; return e; }
    __device__ float load(int grp, int rt, int r, int k) const { return bf2f(A[(size_t)(rt * 64 + r) * EFF + k]); } };
struct BlPlain { const float* W; int ldb; int pad; __device__ float load(int grp, int k, int col) const { return W[(size_t)k * ldb + col]; } };
struct BlSwiglu { const float* Wg; const float* Wu; size_t estride;
    __device__ float load(int grp, int k, int col) const { const int ff = (col >> 6) * 32 + (col & 31); const float* W = (col & 32) ? Wu : Wg; return W[(size_t)grp * estride + (size_t)k * EFF + ff]; } };
struct BlExp { const float* W; size_t estride; int ldb; int pad; __device__ float load(int grp, int k, int col) const { return W[(size_t)grp * estride + (size_t)k * ldb + col]; } };

template <int K, class AL, class BL, class EP>
__global__ void __launch_bounds__(256) k_gemm64(AL al, BL bl, EP ep) {
    __shared__ float As[16][68], Bs[16][68];
    __shared__ float Ct[64][65];
    const int tid = threadIdx.x, tx = tid & 15, ty = tid >> 4, col0 = blockIdx.x * 64, rt = blockIdx.y;
    const int grp = al.group(rt); if (grp < 0) return;
    float acc[4][4];
#pragma unroll
    for (int i = 0; i < 4; ++i)
#pragma unroll
        for (int j = 0; j < 4; ++j) acc[i][j] = 0.f;
    for (int k0 = 0; k0 < K; k0 += 16) {
#pragma unroll
        for (int i = 0; i < 4; ++i) { const int e = tid + 256 * i, r = e >> 4, kk = e & 15; As[kk][r] = al.load(grp, rt, r, k0 + kk); }
#pragma unroll
        for (int i = 0; i < 4; ++i) { const int e = tid + 256 * i, kk = e >> 6, cc = e & 63; Bs[kk][cc] = bl.load(grp, k0 + kk, col0 + cc); }
        __syncthreads();
#pragma unroll
        for (int kk = 0; kk < 16; ++kk) {
            float a[4], b[4];
#pragma unroll
            for (int i = 0; i < 4; ++i) { a[i] = As[kk][ty * 4 + i]; b[i] = Bs[kk][tx * 4 + i]; }
#pragma unroll
            for (int i = 0; i < 4; ++i)
#pragma unroll
                for (int j = 0; j < 4; ++j) acc[i][j] += a[i] * b[j];
        }
        __syncthreads();
    }
#pragma unroll
    for (int i = 0; i < 4; ++i)
#pragma unroll
        for (int j = 0; j < 4; ++j) Ct[ty * 4 + i][tx * 4 + j] = acc[i][j];
    __syncthreads();
    ep(Ct, grp, rt, col0, tid);
}

struct EpP1 {
    const float* rope; const float* qn_g; const float* kn_g; const float* b_gate; unsigned char* ws;
    __device__ void operator()(const float (*Ct)[65], int grp, int rt, int col0, int tid) const {
        const int row0 = rt * 64;
        const float* C1 = rope; const float* S1 = rope + 65536; const float* CR = rope + 131072; const float* SR = CR + 512; const float* CC = SR + 512; const float* SC = CC + 1024;
        if (col0 < C_VA) {
            const bool isq = col0 < C_KA; bf16* O = (bf16*)(ws + (isq ? WS_QA : WS_KA)); const int hc = isq ? col0 : col0 - C_KA; const float sc = isq ? QSCALE : 1.f;
            for (int e = tid; e < 64 * 32; e += 256) { const int r = e >> 5, d = e & 31; const int t = (row0 + r) % SEQ;
                const float x1 = Ct[r][d], x2 = Ct[r][d + 32], c = C1[t * 32 + d], s = S1[t * 32 + d];
                O[(size_t)(row0 + r) * DILW + hc + d] = f2bf((x1 * c - x2 * s) * sc); O[(size_t)(row0 + r) * DILW + hc + d + 32] = f2bf((x2 * c + x1 * s) * sc); }
        } else if (col0 < C_QB) {
            bf16* O = (bf16*)(ws + WS_VA); const int hc = col0 - C_VA;
            for (int e = tid; e < 64 * 64; e += 256) { const int r = e >> 6, d = e & 63; O[(size_t)(row0 + r) * DILW + hc + d] = f2bf(Ct[r][d]); }
        } else if (col0 < C_VB) {
            const bool isq = col0 < C_KB; bf16* O = (bf16*)(ws + (isq ? WS_QB : WS_KB)); const int hc = isq ? col0 - C_QB : col0 - C_KB; const int ld = isq ? GQW : GKW;
            const float* g = isq ? qn_g : kn_g; const float sc = isq ? QSCALE : 1.f;
            const int r = tid >> 2, q4 = tid & 3; float ss = 0.f;
            for (int d = 0; d < 64; ++d) ss += Ct[r][d] * Ct[r][d];
            const float rstd = 1.f / sqrtf(ss * (1.f / 64.f) + NORM_EPS);
            const int t = (row0 + r) % SEQ, rp = t >> 6, cp = t & 63;
            for (int i = 0; i < 8; ++i) { const int p = q4 * 8 + i;
                const int j = p & 15, d = (p < 16) ? j : 32 + j;
                const float c = (p < 16) ? CR[rp * 16 + j] : CC[cp * 16 + j], s = (p < 16) ? SR[rp * 16 + j] : SC[cp * 16 + j];
                const float y1 = Ct[r][d] * rstd * g[d], y2 = Ct[r][d + 16] * rstd * g[d + 16];
                O[(size_t)(row0 + r) * ld + hc + d] = f2bf((y1 * c - y2 * s) * sc); O[(size_t)(row0 + r) * ld + hc + d + 16] = f2bf((y2 * c + y1 * s) * sc); }
        } else if (col0 < C_GT) {
            bf16* O = (bf16*)(ws + WS_VB); const int hc = col0 - C_VB;
            for (int e = tid; e < 64 * 64; e += 256) { const int r = e >> 6, d = e & 63; O[(size_t)(row0 + r) * GKW + hc + d] = f2bf(Ct[r][d]); }
        } else {
            bf16* O = (bf16*)(ws + WS_GATES); const int hc = col0 - C_GT;
            for (int e = tid; e < 64 * 64; e += 256) { const int r = e >> 6, d = e & 63; O[(size_t)(row0 + r) * 2048 + hc + d] = f2bf(sigmoidf_(Ct[r][d] + b_gate[hc + d])); }
        }
    }
};
struct EpYa { const bf16* gates; float* ya;
    __device__ void operator()(const float (*Ct)[65], int grp, int rt, int col0, int tid) const {
        for (int e = tid; e < 4096; e += 256) { const int r = e >> 6, d = e & 63; const size_t row = rt * 64 + r; ya[row * DM + col0 + d] = bf2f(gates[row * 2048 + col0 + d]) * Ct[r][d]; } } };
struct EpGated { const bf16* gates; const float* ya; bf16* gated;
    __device__ void operator()(const float (*Ct)[65], int grp, int rt, int col0, int tid) const {
        for (int e = tid; e < 4096; e += 256) { const int r = e >> 6, d = e & 63; const size_t row = rt * 64 + r; gated[row * DM + col0 + d] = f2bf(ya[row * DM + col0 + d] + bf2f(gates[row * 2048 + 1024 + col0 + d]) * Ct[r][d]); } } };
struct EpXmid { const float* x; const float* mod; float* xmid;
    __device__ void operator()(const float (*Ct)[65], int grp, int rt, int col0, int tid) const {
        for (int e = tid; e < 4096; e += 256) { const int r = e >> 6, d = e & 63; const size_t row = rt * 64 + r; const int b = (int)(row / SEQ);
            xmid[row * DM + col0 + d] = x[row * DM + col0 + d] + mod[(size_t)b * 6144 + 2 * DM + col0 + d] * Ct[r][d]; } } };
struct EpLogits { float* lg;
    __device__ void operator()(const float (*Ct)[65], int grp, int rt, int col0, int tid) const {
        for (int e = tid; e < 4096; e += 256) { const int r = e >> 6, d = e & 63; lg[(size_t)(rt * 64 + r) * NEXP + col0 + d] = Ct[r][d]; } } };
struct EpSwiglu { bf16* act;
    __device__ void operator()(const float (*Ct)[65], int grp, int rt, int col0, int tid) const {
        const int ff0 = (col0 >> 6) * 32;
        for (int e = tid; e < 64 * 32; e += 256) { const int r = e >> 5, j = e & 31; const float g = Ct[r][j], u = Ct[r][j + 32];
            act[(size_t)(rt * 64 + r) * EFF + ff0 + j] = f2bf(g / (1.f + __expf(-g)) * u); } } };
struct EpShDown { const float* mod; float* xo;
    __device__ void operator()(const float (*Ct)[65], int grp, int rt, int col0, int tid) const {
        for (int e = tid; e < 4096; e += 256) { const int r = e >> 6, d = e & 63; const size_t row = rt * 64 + r; const int b = (int)(row / SEQ);
            xo[row * DM + col0 + d] += mod[(size_t)b * 6144 + 5 * DM + col0 + d] * Ct[r][d]; } } };
struct EpExpDown { const float* mod; float* xo; RouteTabs R;
    __device__ void operator()(const float (*Ct)[65], int grp, int rt, int col0, int tid) const {
        for (int e = tid; e < 4096; e += 256) { const int r = e >> 6, d = e & 63; const int slot = rt * 64 + r; const int tok = R.stok[slot] >> 3; if (tok < 0) continue; const int b = tok / SEQ;
            atomicAdd(&xo[(size_t)tok * DM + col0 + d], mod[(size_t)b * 6144 + 5 * DM + col0 + d] * R.sgate[slot] * Ct[r][d]); } } };

__global__ void __launch_bounds__(64) k_gqa_naive(const bf16* QB, const bf16* KB, const bf16* VB, bf16* ATT) {
    const int h = blockIdx.y, b = blockIdx.z, t = blockIdx.x * 64 + threadIdx.x; const int kvh = h >> 2;
    const size_t row = (size_t)b * SEQ + t;
    float q[64], o[64];
#pragma unroll
    for (int d = 0; d < 64; ++d) { q[d] = bf2f(QB[row * GQW + h * 64 + d]); o[d] = 0.f; }
    float m = -1e30f, l = 0.f;
    for (int j = 0; j < SEQ; ++j) {
        const bf16* kr = KB + ((size_t)b * SEQ + j) * GKW + kvh * 64; const bf16* vr = VB + ((size_t)b * SEQ + j) * GKW + kvh * 64;
        float s = 0.f;
#pragma unroll
        for (int d = 0; d < 64; ++d) s += q[d] * bf2f(kr[d]);
        const float mn = fmaxf(m, s), corr = exp2f(m - mn), p = exp2f(s - mn);
        l = l * corr + p; m = mn;
#pragma unroll
        for (int d = 0; d < 64; ++d) o[d] = o[d] * corr + p * bf2f(vr[d]);
    }
    const float il = 1.f / l;
#pragma unroll
    for (int d = 0; d < 64; ++d) ATT[row * 1280 + 256 + h * 64 + d] = f2bf(o[d] * il);
}
__global__ void __launch_bounds__(64) k_dil_naive(const bf16* QA, const bf16* KA, const bf16* VA, bf16* ATT) {
    const int hh = blockIdx.y, b = blockIdx.z, t = blockIdx.x * 64 + threadIdx.x;
    const size_t row = (size_t)b * SEQ + t;
    float q[64], o[64];
#pragma unroll
    for (int d = 0; d < 64; ++d) o[d] = 0.f;
    float m = -1e30f, l = 0.f;
    for (int g = 0; g < 3; ++g) {
        const int dil = (g == 0) ? 1 : (g == 1) ? 4 : 16; const int hc = (g * 4 + hh) * 64;
#pragma unroll
        for (int d = 0; d < 64; ++d) q[d] = bf2f(QA[row * DILW + hc + d]);
        for (int j = -64; j <= 64; ++j) {
            const int t2 = t + j * dil; if (t2 < 0 || t2 >= SEQ) continue;
            const bf16* kr = KA + ((size_t)b * SEQ + t2) * DILW + hc; const bf16* vr = VA + ((size_t)b * SEQ + t2) * DILW + hc;
            float s = 0.f;
#pragma unroll
            for (int d = 0; d < 64; ++d) s += q[d] * bf2f(kr[d]);
            const float mn = fmaxf(m, s), corr = exp2f(m - mn), p = exp2f(s - mn);
            l = l * corr + p; m = mn;
#pragma unroll
            for (int d = 0; d < 64; ++d) o[d] = o[d] * corr + p * bf2f(vr[d]);
        }
    }
    const float il = 1.f / l;
#pragma unroll
    for (int d = 0; d < 64; ++d) ATT[row * 1280 + hh * 64 + d] = f2bf(o[d] * il);
}

__global__ void __launch_bounds__(256) k_topk(const float* logits, const float* rbias, int* IDX, float* GATEV, int* POSE, int* counts) {
    const int t = blockIdx.x * 4 + (threadIdx.x >> 6), lane = threadIdx.x & 63;
    const float4 lg = *(const float4*)(logits + (size_t)t * NEXP + 4 * lane); const float4 rb = *(const float4*)(rbias + 4 * lane);
    float s[4] = {sigmoidf_(lg.x), sigmoidf_(lg.y), sigmoidf_(lg.z), sigmoidf_(lg.w)};
    float v[4] = {s[0] + rb.x, s[1] + rb.y, s[2] + rb.z, s[3] + rb.w};
    float m1 = fmaxf(v[0], v[1]), m2 = fminf(v[0], v[1]);
    { const float a = fmaxf(v[2], v[3]), c = fminf(v[2], v[3]); const float n1 = fmaxf(m1, a); const float n2 = fmaxf(fminf(m1, a), fmaxf(m2, c)); m1 = n1; m2 = n2; }
#pragma unroll
    for (int o = 1; o < 8; o <<= 1) { const float a1 = __shfl_xor(m1, o), a2 = __shfl_xor(m2, o); const float n1 = fmaxf(m1, a1); const float n2 = fmaxf(fminf(m1, a1), fmaxf(m2, a2)); m1 = n1; m2 = n2; }
    const float gs = m1 + m2; const int grp = lane >> 3; int rank = 0;
#pragma unroll
    for (int g2 = 0; g2 < 8; ++g2) { const float o = __shfl(gs, 8 * g2); rank += (o > gs || (o == gs && g2 < grp)) ? 1 : 0; }
    const bool sel = rank < 4;
#pragma unroll
    for (int i = 0; i < 4; ++i) if (!sel) v[i] = -INFINITY;
    int myidx = 0; float mysc = 0.f; float ssum = 0.f;
    for (int k = 0; k < TOPK; ++k) {
        float bv = v[0]; int bi = 4 * lane;
#pragma unroll
        for (int i = 1; i < 4; ++i) if (v[i] > bv) { bv = v[i]; bi = 4 * lane + i; }
#pragma unroll
        for (int o = 1; o < 64; o <<= 1) { const float ov = __shfl_xor(bv, o); const int oi = __shfl_xor(bi, o); if (ov > bv || (ov == bv && oi < bi)) { bv = ov; bi = oi; } }
        const int wl = bi >> 2, wi = bi & 3;
        float sc = 0.f;
        if (lane == wl) {
#pragma unroll
            for (int i = 0; i < 4; ++i) if (i == wi) { sc = s[i]; v[i] = -INFINITY; }
        }
        sc = __shfl(sc, wl); ssum += sc;
        if (lane == k) { myidx = bi; mysc = sc; }
    }
    if (lane < TOPK) {
        const int chunk = t / CH_TOK;
        IDX[(size_t)t * TOPK + lane] = myidx; GATEV[(size_t)t * TOPK + lane] = mysc / ssum * 2.5f;
        POSE[(size_t)t * TOPK + lane] = atomicAdd(&counts[chunk * NEXP + myidx], 1);
    }
}
__global__ void k_scan(const int* counts, int* misc) {
    if (threadIdx.x < NCHUNK) { const int c = threadIdx.x; int run = 0;
        for (int e = 0; e < NEXP; ++e) { const int n = counts[c * NEXP + e]; misc[MW_PSTART + c * NEXP + e] = run; run += (n + 255) & ~255; misc[MW_PEND + c * NEXP + e] = run; misc[MW_CNT + c * NEXP + e] = n; } }
}
__global__ void k_scatter(const int* IDX, const float* GATEV, const int* POSE, const int* misc, int* STOK, float* SGATE) {
    const int i = blockIdx.x * 256 + threadIdx.x; const int t = i >> 3; const int c = t / CH_TOK; const int e = IDX[i];
    const int slot = c * CH_SLOTS + misc[MW_PSTART + c * NEXP + e] + POSE[i];
    STOK[slot] = i; SGATE[slot] = GATEV[i];
}

__device__ __forceinline__ int hw_tid(int wave) { int l_; asm volatile("v_mbcnt_lo_u32_b32 %0, -1, 0\n\tv_mbcnt_hi_u32_b32 %0, -1, %0" : "=v"(l_)); return (wave << 6) | l_; }
namespace pg8 {
#define PG8_LAS __attribute__((address_space(3)))
typedef unsigned short bf16_t;
typedef short bf16x8 __attribute__((ext_vector_type(8)));
typedef float f32x4 __attribute__((ext_vector_type(4)));
typedef unsigned u32x4 __attribute__((ext_vector_type(4)));
typedef unsigned u32x2 __attribute__((ext_vector_type(2)));
constexpr int BM = 256, BK = 64, HALF = 128, HTB = HALF * BK * 2, STAGE_BYTES = 8 * HTB, NXCD = 8, WGM = 8;
__host__ __device__ __forceinline__ int lds_byte(int r, int c) { const int st = (r >> 4) * 2 + (c >> 5), rr = r & 15, cc = c & 31, ob = rr * 64 + cc * 2; return st * 1024 + (ob ^ (((ob >> 9) & 1) << 5)); }
__host__ __device__ __forceinline__ void stage_rc(int b, int& R, int& C) { const int st = b / 1024, sb = b % 1024, swz = sb ^ (((sb >> 9) & 1) << 5); R = (st >> 1) * 16 + swz / 64; C = (st & 1) * 32 + (swz % 64) / 2; }
__host__ __device__ __forceinline__ int perm32(int rho) { const int n = rho >> 4, i = rho & 15; return 8 * (i >> 2) + 4 * n + (i & 3); }
struct Unit { int pm, pn; };
struct Gemm { const bf16_t* A; const bf16_t* Bt; int M, N, K, lda, ldb; };
struct StaticOrder {
    int nM, nN, nwg, G, c;
    __host__ __device__ void init(int M, int N, int G_, int c_) { nM = M / BM; nN = N / BM; nwg = nM * nN; G = G_; c = c_; }
    __host__ __device__ bool next(int i, Unit& u) const {
        const long L = (long)i * G + c; if (L >= nwg) return false;
        int wgid = (int)L; { const int q = nwg / NXCD, r = nwg % NXCD, xcd = wgid % NXCD, off = wgid / NXCD; wgid = (xcd < r ? xcd * (q + 1) : r * (q + 1) + (xcd - r) * q) + off; }
        const int nig = WGM * nN, gid = wgid / nig, fm = gid * WGM, gsz = (nM - fm) < WGM ? (nM - fm) : WGM;
        u.pm = fm + ((wgid % nig) % gsz); u.pn = (wgid % nig) / gsz; return true;
    }
    __device__ __forceinline__ void a_ready(const Unit&) const {}
    __device__ __forceinline__ void done(const Unit&) const {}
};
__device__ __forceinline__ unsigned cvt_pk_bf16(float lo, float hi) { unsigned r; asm volatile("v_cvt_pk_bf16_f32 %0, %1, %2" : "=v"(r) : "v"(lo), "v"(hi)); return r; }

template <class T, class = void> struct epi_f8 { static constexpr bool v = false; };
template <class T> struct epi_f8<T, decltype((void)T::F8)> { static constexpr bool v = T::F8; };
template <class Epi, class Sched>
__device__ __forceinline__ void gemm_phase(PG8_LAS unsigned char* lds, const Gemm g, const Sched& S, const Epi& E, const int wv) {
    int tid = hw_tid(wv);
    const int wid = __builtin_amdgcn_readfirstlane(tid >> 6), lane = tid & 63, wr = wid >> 2, wc = wid & 3, fr = lane & 15, fq = lane >> 4;
    constexpr bool F8 = epi_f8<Epi>::v; constexpr int ES = F8 ? 1 : 2;
    const int K = g.K, nt = K * ES / (BK * 2);
    unsigned voffA[2], voffB[2];
#pragma unroll
    for (int i = 0; i < 2; ++i) { int R, C; stage_rc(tid * 16 + i * 8192, R, C); const int Rb = Epi::PERM ? ((R & ~31) + perm32(R & 31)) : R;
        voffA[i] = (unsigned)(R * g.lda * ES + C * 2); voffB[i] = (unsigned)(Rb * g.ldb * ES + C * 2); }
    const size_t kstep = (size_t)(BK * 2);
    const size_t hstepA = (size_t)HALF * g.lda * ES, hstepB = (size_t)HALF * g.ldb * ES;
    const size_t tstepA = 2 * hstepA, tstepB = 2 * hstepB;
    const unsigned ldsw = (unsigned)wid * 1024u;
    const int aoff = lds_byte(wr * 64 + fr, fq * 8), boff = lds_byte(wc * 32 + fr, fq * 8);
#define PG8_SA(b, h) (((b) * 2 + (h)) * HTB)
#define PG8_SB(b, h) ((4 + (b) * 2 + (h)) * HTB)
#define PG8_STAGE(bufoff, gbase, voff) do { _Pragma("unroll") for (int _i = 0; _i < 2; ++_i) { unsigned o_ = (voff)[_i]; if constexpr (F8) asm volatile("" : "+v"(o_));   \
        __builtin_amdgcn_global_load_lds((const unsigned*)((const char*)(gbase) + o_), (PG8_LAS unsigned*)(lds + (bufoff) + ldsw + _i * 8192), 16, 0, 0); } } while (0)
#define PG8_LDA(dst, b, h) do { _Pragma("unroll") for (int m = 0; m < 4; ++m) _Pragma("unroll") for (int k = 0; k < 2; ++k) dst[m][k] = *(const PG8_LAS bf16x8*)(lds + PG8_SA(b, h) + aoff + m * 2048 + k * 1024); } while (0)
#define PG8_LDB(dst, b, h) do { _Pragma("unroll") for (int n = 0; n < 2; ++n) _Pragma("unroll") for (int k = 0; k < 2; ++k) dst[n][k] = *(const PG8_LAS bf16x8*)(lds + PG8_SB(b, h) + boff + n * 2048 + k * 1024); } while (0)
    typedef int i32x8_t __attribute__((ext_vector_type(8))); typedef int i32x4_t __attribute__((ext_vector_type(4)));
#define PG8_CAT(lo, hi) __builtin_shufflevector(__builtin_bit_cast(i32x4_t, lo), __builtin_bit_cast(i32x4_t, hi), 0, 1, 2, 3, 4, 5, 6, 7)
#define PG8_MMA(ai, bj, At, Bt) do { __builtin_amdgcn_s_setprio(1); _Pragma("unroll") for (int m = 0; m < 4; ++m) _Pragma("unroll") for (int n = 0; n < 2; ++n) { \
        if constexpr (F8) acc[ai][bj][m][n] = __builtin_amdgcn_mfma_scale_f32_16x16x128_f8f6f4(PG8_CAT(Bt[n][0], Bt[n][1]), PG8_CAT(At[m][0], At[m][1]), acc[ai][bj][m][n], 0, 0, 0, 0x7F7F7F7F, 0, 0x7F7F7F7F); \
        else { _Pragma("unroll") for (int k = 0; k < 2; ++k) acc[ai][bj][m][n] = __builtin_amdgcn_mfma_f32_16x16x32_bf16(Bt[n][k], At[m][k], acc[ai][bj][m][n], 0, 0, 0); } } \
        __builtin_amdgcn_s_setprio(0); } while (0)
#define PG8_WAIT_V(n) asm volatile("s_waitcnt vmcnt(" #n ")" ::: "memory")
#define PG8_WAIT_L(n) asm volatile("s_waitcnt lgkmcnt(" #n ")" ::: "memory")
#define PG8_BAR __builtin_amdgcn_s_barrier()
#define PG8_SCHED __builtin_amdgcn_sched_barrier(0)
    Unit cur, nxt; int ui = 0;
    if (!S.next(0, cur)) return;
    f32x4 acc[2][2][4][2];
#pragma unroll
    for (int a = 0; a < 2; ++a)
#pragma unroll
        for (int b = 0; b < 2; ++b)
#pragma unroll
            for (int m = 0; m < 4; ++m)
#pragma unroll
                for (int n = 0; n < 2; ++n) acc[a][b][m][n] = (f32x4){0.f, 0.f, 0.f, 0.f};
    bf16x8 At[4][2], B0[2][2], B1[2][2];
    const char* cA = (const char*)g.A + (size_t)cur.pm * tstepA; const char* cB = (const char*)g.Bt + (size_t)cur.pn * tstepB;
    S.a_ready(cur);
    PG8_STAGE(PG8_SB(0, 0), cB, voffB); PG8_STAGE(PG8_SB(0, 1), cB + hstepB, voffB); PG8_STAGE(PG8_SA(0, 0), cA, voffA); PG8_STAGE(PG8_SA(0, 1), cA + hstepA, voffA);
    if (wr == 1) PG8_BAR;
    PG8_WAIT_V(2); PG8_BAR;
    PG8_STAGE(PG8_SB(1, 0), cB + kstep, voffB); PG8_STAGE(PG8_SA(1, 0), cA + kstep, voffA); PG8_STAGE(PG8_SB(1, 1), cB + hstepB + kstep, voffB);
    PG8_WAIT_V(6); PG8_BAR;
    for (;;) {
        const bool has_next = S.next(ui + 1, nxt);
        const char* nA = has_next ? (const char*)g.A + (size_t)nxt.pm * tstepA : cA; const char* nB = has_next ? (const char*)g.Bt + (size_t)nxt.pn * tstepB : cB;
#pragma nounroll
        for (int t = 0; t < nt; t += 2) {
            const bool last = (t == nt - 2);
            const char* a1 = cA + (size_t)(t + 1) * kstep;
            const char* a2 = last ? nA : cA + (size_t)(t + 2) * kstep; const char* b2 = last ? nB : cB + (size_t)(t + 2) * kstep;
            const char* a3 = a2 + kstep; const char* b3 = b2 + kstep;
            if (last && has_next) S.a_ready(nxt);
            if constexpr (Epi::HOOK_T >= 0) { if (t == Epi::HOOK_T) E.hook(acc, cur, wr, wc, fr, fq); }
            PG8_LDB(B0, 0, 0); PG8_LDB(B1, 0, 1); PG8_SCHED; PG8_LDA(At, 0, 0); PG8_STAGE(PG8_SA(1, 1), a1 + hstepA, voffA);
            PG8_WAIT_V(8); PG8_WAIT_L(0); PG8_BAR; PG8_MMA(0, 0, At, B0); PG8_MMA(0, 1, At, B1); PG8_BAR; PG8_SCHED;
            PG8_LDA(At, 0, 1); PG8_STAGE(PG8_SB(0, 0), b2, voffB); PG8_STAGE(PG8_SB(0, 1), b2 + hstepB, voffB); PG8_STAGE(PG8_SA(0, 0), a2, voffA);
            PG8_WAIT_V(8); PG8_WAIT_L(0); PG8_BAR; PG8_MMA(1, 0, At, B0); PG8_MMA(1, 1, At, B1); PG8_BAR; PG8_SCHED;
            PG8_LDB(B0, 1, 0); PG8_LDB(B1, 1, 1); PG8_SCHED; PG8_LDA(At, 1, 0); PG8_STAGE(PG8_SA(0, 1), a2 + hstepA, voffA);
            PG8_WAIT_V(8); PG8_WAIT_L(0); PG8_BAR; PG8_MMA(0, 0, At, B0); PG8_MMA(0, 1, At, B1); PG8_BAR; PG8_SCHED;
            PG8_LDA(At, 1, 1); PG8_STAGE(PG8_SB(1, 0), b3, voffB); PG8_STAGE(PG8_SB(1, 1), b3 + hstepB, voffB); PG8_STAGE(PG8_SA(1, 0), a3, voffA);
            PG8_WAIT_V(8); PG8_WAIT_L(0); PG8_BAR; PG8_MMA(1, 0, At, B0); PG8_MMA(1, 1, At, B1); PG8_BAR; PG8_SCHED;
        }
        if (wr == 0) PG8_BAR;
        { int t_ = tid; asm volatile("" : "+v"(t_)); E(acc, cur, wr, wc, t_ & 15, (t_ >> 4) & 3); } S.done(cur);
        if (!has_next) break;
#pragma unroll
        for (int a = 0; a < 2; ++a)
#pragma unroll
            for (int b = 0; b < 2; ++b)
#pragma unroll
                for (int m = 0; m < 4; ++m)
#pragma unroll
                    for (int n = 0; n < 2; ++n) acc[a][b][m][n] = (f32x4){0.f, 0.f, 0.f, 0.f};
        cur = nxt; cA = nA; cB = nB; ++ui;
        if (wr == 1) PG8_BAR;
    }
    PG8_WAIT_V(0);
    PG8_BAR;
#undef PG8_SA
#undef PG8_SB
#undef PG8_STAGE
#undef PG8_LDA
#undef PG8_LDB
#undef PG8_MMA
#undef PG8_CAT
#undef PG8_WAIT_V
#undef PG8_WAIT_L
#undef PG8_BAR
#undef PG8_SCHED
}
}

#include <hip/hip_bf16.h>
namespace attn_body {
using bf16=__hip_bfloat16;
using bf16x8=__attribute__((ext_vector_type(8)))short;
using s16x4=__attribute__((ext_vector_type(4)))short;
using f32x16=__attribute__((ext_vector_type(16)))float;
using u32x4=__attribute__((ext_vector_type(4)))unsigned;
constexpr int BATCH=32,NHEAD=16,SEQ=2048,D=64,QP=1024,KVP=256,OP=1280,OCOL=256;
constexpr int NW=8,QBLK=32,QB=QBLK*NW,KVBLK=64,NQB=SEQ/QB;
constexpr int ATTN_UNIT_ROWS=QB;
__device__ __forceinline__ int crow(int r,int hi){return (r&3)+8*(r>>2)+4*hi;}
#define SBAR() __builtin_amdgcn_sched_barrier(0)
__device__ __forceinline__ void cmask(f32x16&p0,f32x16&p1,int jb,int qrel,int hi){
  const float NEG=-INFINITY; int kb=64*jb+4*hi;
  #pragma unroll
  for(int r=0;r<16;++r){int kv=kb+(r&3)+8*(r>>2); if(kv>qrel)p0[r]=NEG; if(kv+32>qrel)p1[r]=NEG;}
}

constexpr int NSLOT=3, SLOTB=8192;
constexpr int LDS_K=0, LDS_V=NSLOT*SLOTB, LDS_WS=2*NSLOT*SLOTB, LDS_OST=LDS_WS+NW*64*4, LDS_BYTES=LDS_OST+NW*4096;
constexpr float C2=0.125f*1.4426950408889634f;
__device__ __forceinline__ void glds16(const void*gsrc,unsigned lds_dst){unsigned keep;
  asm volatile("s_mov_b32 %0, m0\n\ts_mov_b32 m0, %2\n\ts_nop 0\n\tglobal_load_lds_dwordx4 %1, off\n\ts_mov_b32 m0, %0":"=&s"(keep):"v"(gsrc),"s"(lds_dst):"memory");}
__device__ __forceinline__ float max3f(float a,float b,float c){float r;asm("v_max3_f32 %0, %1, %2, %3":"=v"(r):"v"(a),"v"(b),"v"(c));return r;}
__device__ __forceinline__ float max2f(float a,float b){float r;asm("v_max_f32_e32 %0, %1, %2":"=v"(r):"v"(a),"v"(b));return r;}
__device__ __forceinline__ float fadd_s(float a,float b){float r;asm("v_add_f32_e32 %0, %1, %2":"=v"(r):"v"(a),"v"(b));return r;}
__device__ __forceinline__ float fsub_s(float a,float b){float r;asm("v_sub_f32_e32 %0, %1, %2":"=v"(r):"v"(a),"v"(b));return r;}
typedef float f32x2_t __attribute__((ext_vector_type(2))); typedef __bf16 bf16x2_t __attribute__((ext_vector_type(2)));
__device__ __forceinline__ unsigned cvtpk_s(float lo,float hi){f32x2_t v={lo,hi};bf16x2_t b=__builtin_convertvector(v,bf16x2_t);return __builtin_bit_cast(unsigned,b);}
#define WAIT_BAR(N) asm volatile("s_waitcnt vmcnt(" #N ") lgkmcnt(0)\n\ts_barrier":::"memory")

__device__ __forceinline__ void qkt(f32x16&p0,f32x16&p1,const char*Kslot,const bf16x8*qr,const f32x16&negm,int r32,int hi){
  const char*kb=Kslot+hi*1024+r32*16;
  #pragma unroll
  for(int d0=0;d0<4;++d0){
    const bf16x8 b0=*reinterpret_cast<const bf16x8*>(kb+d0*2048);
    const bf16x8 b1=*reinterpret_cast<const bf16x8*>(kb+d0*2048+512);
    if(d0==0){p0=__builtin_amdgcn_mfma_f32_32x32x16_bf16(b0,qr[0],negm,0,0,0);p1=__builtin_amdgcn_mfma_f32_32x32x16_bf16(b1,qr[0],negm,0,0,0);}
    else{p0=__builtin_amdgcn_mfma_f32_32x32x16_bf16(b0,qr[d0],p0,0,0,0);p1=__builtin_amdgcn_mfma_f32_32x32x16_bf16(b1,qr[d0],p1,0,0,0);}}
}
typedef __attribute__((address_space(3))) const char* lds_cptr;
typedef short v4i16_t __attribute__((ext_vector_type(4)));
__device__ __forceinline__ void kload8(bf16x8*kf,lds_cptr kp){
  kf[0]=*(const __attribute__((address_space(3))) bf16x8*)(kp);      kf[1]=*(const __attribute__((address_space(3))) bf16x8*)(kp+512);
  kf[2]=*(const __attribute__((address_space(3))) bf16x8*)(kp+2048); kf[3]=*(const __attribute__((address_space(3))) bf16x8*)(kp+2560);
  kf[4]=*(const __attribute__((address_space(3))) bf16x8*)(kp+4096); kf[5]=*(const __attribute__((address_space(3))) bf16x8*)(kp+4608);
  kf[6]=*(const __attribute__((address_space(3))) bf16x8*)(kp+6144); kf[7]=*(const __attribute__((address_space(3))) bf16x8*)(kp+6656);
}
__device__ __forceinline__ void kload2(bf16x8*kf,lds_cptr kp,int j){ kf[2*j]=*(const __attribute__((address_space(3))) bf16x8*)(kp+j*2048); kf[2*j+1]=*(const __attribute__((address_space(3))) bf16x8*)(kp+j*2048+512); }
__device__ __forceinline__ s16x4 vtr(lds_cptr p){ return __builtin_bit_cast(s16x4,__builtin_amdgcn_ds_read_tr16_b64_v4i16((__attribute__((address_space(3))) v4i16_t*)p)); }
__device__ __forceinline__ float rowmax(const f32x16&p0,const f32x16&p1){
  float a=max3f(p0[0],p0[1],p1[0]),b=max3f(p0[2],p0[3],p1[1]);a=max3f(a,p1[2],p1[3]);
  #pragma unroll
  for(int r=4;r<16;r+=4){a=max3f(a,p0[r],p0[r+1]);b=max3f(b,p0[r+2],p0[r+3]);a=max3f(a,p1[r],p1[r+1]);b=max3f(b,p1[r+2],p1[r+3]);}
  const float m=max2f(a,b);
  auto rr=__builtin_amdgcn_permlane32_swap(__float_as_uint(m),__float_as_uint(m),false,false);
  return max2f(__uint_as_float(rr[0]),__uint_as_float(rr[1]));
}
__device__ __forceinline__ void pv(f32x16*o,int vb,bf16x8 pa0,bf16x8 pa1,bf16x8 pa2,bf16x8 pa3){
  #pragma unroll
  for(int d0=0;d0<2;++d0){s16x4 lo[4],hi[4];
    #pragma unroll
    for(int ks=0;ks<4;++ks){
      asm volatile("ds_read_b64_tr_b16 %0,%1 offset:%c2":"=&v"(lo[ks]):"v"(vb),"i"(d0*4096+ks*1024):"memory");
      asm volatile("ds_read_b64_tr_b16 %0,%1 offset:%c2":"=&v"(hi[ks]):"v"(vb),"i"(d0*4096+ks*1024+512):"memory");}
    asm volatile("s_waitcnt lgkmcnt(0)":::"memory");SBAR();
    #define PK(k) (bf16x8){lo[k][0],lo[k][1],lo[k][2],lo[k][3],hi[k][0],hi[k][1],hi[k][2],hi[k][3]}
    o[d0]=__builtin_amdgcn_mfma_f32_32x32x16_bf16(pa0,PK(0),o[d0],0,0,0);
    o[d0]=__builtin_amdgcn_mfma_f32_32x32x16_bf16(pa1,PK(1),o[d0],0,0,0);
    o[d0]=__builtin_amdgcn_mfma_f32_32x32x16_bf16(pa2,PK(2),o[d0],0,0,0);
    o[d0]=__builtin_amdgcn_mfma_f32_32x32x16_bf16(pa3,PK(3),o[d0],0,0,0);
    #undef PK
  }
}

#ifndef ATTN_STORE16
#define ATTN_STORE16(p,v) (*(u32x4*)(p)=(v))
#endif
template<int THRL> __device__ __forceinline__ void attn_unit(int b,int h,int qb,const bf16*Q,const bf16*__restrict__ K,const bf16*__restrict__ V,bf16*O,char*shm,const int wv){
  const int tid=hw_tid(wv),lane=tid&63,r32=lane&31,hi=lane>>5; const int wid=wv;
  const long rowbase=(long)b*SEQ; const int q0=qb*QB;
  const bf16*Qw=Q+(rowbase+q0+wid*QBLK)*QP+h*D;
  const bf16*Kh=K+rowbase*KVP+(h>>2)*D,*Vh=V+rowbase*KVP+(h>>2)*D;
  const unsigned lds0=(unsigned)(uintptr_t)shm;
  float*wsf=(float*)(shm+LDS_WS)+wid*64;
  const bf16*ksrc=Kh+(long)lane*KVP+wid*8;
  const bf16*vsrc=Vh+(long)(16*(wid&3)+(lane>>2))*KVP+(wid>>2)*32+(lane&3)*8;
  const unsigned kdst=lds0+LDS_K+wid*1024, vdst=lds0+LDS_V+wid*1024;
  #define DMA_K(t,slot) glds16(ksrc+(long)(t)*KVBLK*KVP,(unsigned)__builtin_amdgcn_readfirstlane(kdst+(slot)))
  #define DMA_V(t,slot) glds16(vsrc+(long)(t)*KVBLK*KVP,(unsigned)__builtin_amdgcn_readfirstlane(vdst+(slot)))
  const int vb0=(int)(lds0+LDS_V)+((lane>>4)&1)*32+(lane&3)*8+(4*hi+((lane&15)>>2))*64;
  const char*Kbase=shm+LDS_K; bf16x8 kf[8];
  const lds_cptr shm3=(lds_cptr)shm; const lds_cptr kp0=shm3+LDS_K+hi*1024+r32*16; const lds_cptr vp0=shm3+LDS_V+((lane>>4)&1)*32+(lane&3)*8+(4*hi+((lane&15)>>2))*64;
  constexpr int NT=SEQ/KVBLK;
  DMA_K(0,0);DMA_V(0,0);DMA_K(1,SLOTB);
  bf16x8 qr[4];
  #pragma unroll
  for(int d0=0;d0<4;++d0)qr[d0]=*reinterpret_cast<const bf16x8*>(&Qw[(long)r32*QP+d0*16+hi*8]);
  float mhat=0.f,l_reg=0.f;f32x16 o[2];o[0]=f32x16{};o[1]=f32x16{};f32x16 negm=f32x16{};asm volatile("":"+v"(negm));
  (void)0;
  #define CMASK(P0,P1,t) do{}while(0)
  bool resc=false;
  #define START(P0,P1) do{ const float rm=rowmax(P0,P1); resc=false; \
    { const float dl=rm; mhat=fadd_s(mhat,dl); \
      _Pragma("unroll") for(int r=0;r<16;++r){P0[r]=fsub_s(P0[r],dl);P1[r]=fsub_s(P1[r],dl);} \
      _Pragma("unroll") for(int r=0;r<16;++r)negm[r]=-mhat; asm volatile("":"+v"(negm)); } \
    _Pragma("unroll") for(int r=0;r<16;++r)P0[r]=__builtin_amdgcn_exp2f(P0[r]); }while(0)
  #define RESC() do{ if(resc){ asm volatile("s_waitcnt lgkmcnt(0)":::"memory"); \
      _Pragma("unroll") for(int d_=0;d_<2;++d_) _Pragma("unroll") for(int r=0;r<16;++r)o[d_][r]*=wsf[crow(r,hi)]; } }while(0)
  f32x16 pA0,pA1,pB0,pB1;
  int sl_prev=0,sl_cur=0,sl_next=SLOTB;
  #define ROT() do{sl_prev=sl_cur;sl_cur=sl_next;sl_next=(sl_next==(NSLOT-1)*SLOTB)?0:sl_next+SLOTB;}while(0)
  DMA_K(2,2*SLOTB);
  WAIT_BAR(3);
  qkt(pA0,pA1,Kbase,qr,negm,r32,hi);asm volatile("s_nop 15\n\ts_nop 7":"+v"(pA0),"+v"(pA1));CMASK(pA0,pA1,0);
  START(pA0,pA1);
  _Pragma("unroll") for(int r=0;r<16;++r)pA1[r]=__builtin_amdgcn_exp2f(pA1[r]);
  WAIT_BAR(0);
  DMA_K(3,0);DMA_V(1,SLOTB);
  ROT();
  kload8(kf,kp0+sl_cur);
  WAIT_BAR(2);
  s16x4 vlo[8],vhi[8]; u32x4 pw0,pw1,pw2,pw3;
  #define PKW(P,B) cvtpk_s(P[B],P[B+1])
  #define PAF(k) __builtin_bit_cast(bf16x8,pw##k)
  #define VFR(i) (bf16x8){vlo[i][0],vlo[i][1],vlo[i][2],vlo[i][3],vhi[i][0],vhi[i][1],vhi[i][2],vhi[i][3]}
  #define PIN(x) asm volatile("":"+v"(x))
  #define MX3(a,b,c) __builtin_fmaxf(__builtin_fmaxf((a),(b)),(c))
  #define GAPA(MF,A0,A1,A2,A3,W0,W1,PW) do{ MF; sacc+=A0; sacc+=A1; sacc+=A2; sacc+=A3; PIN(sacc); W0; W1; PIN(PW); SBAR(); }while(0)
  #define EX(v) __builtin_amdgcn_exp2f(v)
  #define GAPB(MF,X,B) do{ MF; X[B]=EX(X[B]); X[B+1]=EX(X[B+1]); X[B+2]=EX(X[B+2]); X[B+3]=EX(X[B+3]); PIN(X); SBAR(); }while(0)
  #define VRD(i) do{ vlo[i]=vtr(vp_+(((i)>>2)*4096+((i)&3)*1024)); vhi[i]=vtr(vp_+(((i)>>2)*4096+((i)&3)*1024+512)); }while(0)
  #define KRD(G,j) do{ if(G){ kload2(kf,kp0+sl_next,j); SBAR(); } }while(0)
  #define STEP(C0,C1,P0,P1,t,GK,GV,GL) do{ SBAR(); \
    const lds_cptr vp_=vp0+sl_prev; \
    VRD(0); SBAR(); float sacc=(P0[0]+P0[1]); \
    GAPA(C0=__builtin_amdgcn_mfma_f32_32x32x16_bf16(kf[0],qr[0],negm,0,0,0), P0[2],P0[3],P0[4],P0[5],     pw0[0]=PKW(P0,0), pw0[1]=PKW(P0,2), pw0); \
    VRD(4); SBAR(); GAPA(C1=__builtin_amdgcn_mfma_f32_32x32x16_bf16(kf[1],qr[0],negm,0,0,0), P0[6],P0[7],P0[8],P0[9],     pw0[2]=PKW(P0,4), pw0[3]=PKW(P0,6), pw0); \
    VRD(1); SBAR(); GAPA(C0=__builtin_amdgcn_mfma_f32_32x32x16_bf16(kf[2],qr[1],C0,0,0,0),   P0[10],P0[11],P0[12],P0[13], pw1[0]=PKW(P0,8), pw1[1]=PKW(P0,10), pw1); \
    VRD(5); SBAR(); GAPA(C1=__builtin_amdgcn_mfma_f32_32x32x16_bf16(kf[3],qr[1],C1,0,0,0),   P0[14],P0[15],P1[0],P1[1],   pw1[2]=PKW(P0,12),pw1[3]=PKW(P0,14), pw1); \
    VRD(2); SBAR(); GAPA(C0=__builtin_amdgcn_mfma_f32_32x32x16_bf16(kf[4],qr[2],C0,0,0,0),   P1[2],P1[3],P1[4],P1[5],     pw2[0]=PKW(P1,0), pw2[1]=PKW(P1,2), pw2); \
    VRD(6); SBAR(); GAPA(C1=__builtin_amdgcn_mfma_f32_32x32x16_bf16(kf[5],qr[2],C1,0,0,0),   P1[6],P1[7],P1[8],P1[9],     pw2[2]=PKW(P1,4), pw2[3]=PKW(P1,6), pw2); \
    VRD(3); SBAR(); GAPA(C0=__builtin_amdgcn_mfma_f32_32x32x16_bf16(kf[6],qr[3],C0,0,0,0),   P1[10],P1[11],P1[12],P1[13], pw3[0]=PKW(P1,8), pw3[1]=PKW(P1,10), pw3); \
    VRD(7); SBAR(); GAPA(C1=__builtin_amdgcn_mfma_f32_32x32x16_bf16(kf[7],qr[3],C1,0,0,0),   P1[14],P1[15],0.f,0.f,       pw3[2]=PKW(P1,12),pw3[3]=PKW(P1,14), pw3); \
    l_reg+=sacc; \
    if(GK){DMA_K((t)+3,sl_cur);} if(GV){DMA_V((t)+1,sl_next);} \
    CMASK(C0,C1,t); \
    { float a=MX3(C0[0],C0[1],C1[0]),b=MX3(C0[2],C0[3],C1[1]); a=MX3(a,C1[2],C1[3]); \
      _Pragma("unroll") for(int r=4;r<16;r+=4){a=MX3(a,C0[r],C0[r+1]);b=MX3(b,C0[r+2],C0[r+3]);a=MX3(a,C1[r],C1[r+1]);b=MX3(b,C1[r+2],C1[r+3]);} \
      float rm=__builtin_fmaxf(a,b); { auto rr=__builtin_amdgcn_permlane32_swap(__float_as_uint(rm),__float_as_uint(rm),false,false); rm=__builtin_fmaxf(__uint_as_float(rr[0]),__uint_as_float(rr[1])); } \
      resc=false; \
      if(__builtin_expect(__any(rm>(float)THRL),0)){ const float dl=__builtin_fmaxf(rm,0.f); mhat+=dl; \
        _Pragma("unroll") for(int r=0;r<16;++r){C0[r]-=dl;C1[r]-=dl;} \
        _Pragma("unroll") for(int r=0;r<16;++r)negm[r]=-mhat; asm volatile("":"+v"(negm)); \
        const float f=__builtin_amdgcn_exp2f(-dl); l_reg*=f; if(hi==0)wsf[r32]=f; resc=true; } } \
    SBAR(); \
    GAPB(o[0]=__builtin_amdgcn_mfma_f32_32x32x16_bf16(PAF(0),VFR(0),o[0],0,0,0), C0,0); \
    GAPB(o[1]=__builtin_amdgcn_mfma_f32_32x32x16_bf16(PAF(0),VFR(4),o[1],0,0,0), C0,4); \
    KRD(GL,0); GAPB(o[0]=__builtin_amdgcn_mfma_f32_32x32x16_bf16(PAF(1),VFR(1),o[0],0,0,0), C0,8); \
    KRD(GL,1); GAPB(o[1]=__builtin_amdgcn_mfma_f32_32x32x16_bf16(PAF(1),VFR(5),o[1],0,0,0), C0,12); \
    KRD(GL,2); GAPB(o[0]=__builtin_amdgcn_mfma_f32_32x32x16_bf16(PAF(2),VFR(2),o[0],0,0,0), C1,0); \
    KRD(GL,3); GAPB(o[1]=__builtin_amdgcn_mfma_f32_32x32x16_bf16(PAF(2),VFR(6),o[1],0,0,0), C1,4); \
    GAPB(o[0]=__builtin_amdgcn_mfma_f32_32x32x16_bf16(PAF(3),VFR(3),o[0],0,0,0), C1,8); \
    GAPB(o[1]=__builtin_amdgcn_mfma_f32_32x32x16_bf16(PAF(3),VFR(7),o[1],0,0,0), C1,12); \
    }while(0)
  int t=1;
  #undef CMASK
  #define CMASK(P0,P1,t) do{}while(0)
  for(;t+5<NT;t+=2){
    STEP(pB0,pB1,pA0,pA1,t,true,true,true);     WAIT_BAR(2); RESC(); ROT();
    STEP(pA0,pA1,pB0,pB1,t+1,true,true,true);   WAIT_BAR(2); RESC(); ROT();
  }
  #define ENDW(tt) do{ if((tt)+3<NT){WAIT_BAR(2);} else if((tt)+2<NT){WAIT_BAR(1);} else {WAIT_BAR(0);} }while(0)
  for(;t+1<NT;t+=2){
    STEP(pB0,pB1,pA0,pA1,t,(t+3<NT),(t+1<NT),(t+1<NT));       ENDW(t);   RESC(); ROT();
    STEP(pA0,pA1,pB0,pB1,t+1,(t+4<NT),(t+2<NT),(t+2<NT));     ENDW(t+1); RESC(); ROT();
  }
  STEP(pB0,pB1,pA0,pA1,NT-1,false,false,false); RESC();
  { float sacc=pB0[0]+pB0[1]; _Pragma("unroll") for(int r=2;r<16;++r)sacc+=pB0[r]; _Pragma("unroll") for(int r=0;r<16;++r)sacc+=pB1[r]; l_reg+=sacc;
    pw0=(u32x4){PKW(pB0,0),PKW(pB0,2),PKW(pB0,4),PKW(pB0,6)};pw1=(u32x4){PKW(pB0,8),PKW(pB0,10),PKW(pB0,12),PKW(pB0,14)};pw2=(u32x4){PKW(pB1,0),PKW(pB1,2),PKW(pB1,4),PKW(pB1,6)};pw3=(u32x4){PKW(pB1,8),PKW(pB1,10),PKW(pB1,12),PKW(pB1,14)};
    SBAR(); pv(o,vb0+sl_cur,PAF(0),PAF(1),PAF(2),PAF(3)); }
  #undef PKW
  #undef PAF
  #undef VFR
  #undef PIN
  #undef MX3
  #undef GAPA
  #undef GAPB
  #undef EX
  #undef VRD
  #undef KRD
  #undef STEP
  #undef ENDW
  {auto rr=__builtin_amdgcn_permlane32_swap(__float_as_uint(l_reg),__float_as_uint(l_reg),false,false);l_reg=__uint_as_float(rr[0])+__uint_as_float(rr[1]);}
  if(hi==0)wsf[32+r32]=l_reg;asm volatile("s_waitcnt lgkmcnt(0)":::"memory");
  float rli[16];
  #pragma unroll
  for(int r=0;r<16;++r)rli[r]=__builtin_amdgcn_rcpf(wsf[32+crow(r,hi)]);
  unsigned char*Ow=(unsigned char*)O+((rowbase+q0+wid*QBLK)*OP+OCOL+h*D);
  { bf16*stg=(bf16*)(shm+LDS_OST)+wid*2048;
    #pragma unroll
    for(int r=0;r<16;++r){const int orow=crow(r,hi);
      #pragma unroll
      for(int d0=0;d0<2;++d0)stg[orow*64+d0*32+r32]=__float2bfloat16(o[d0][r]*rli[r]);}
    asm volatile("s_waitcnt lgkmcnt(0)":::"memory");
    typedef unsigned u32x2 __attribute__((ext_vector_type(2)));
    #pragma unroll
    for(int i=0;i<4;++i){const int row=i*8+(lane>>3),ch=lane&7; const u32x4 v=*(const u32x4*)(stg+row*64+ch*8); float f[8];
      #pragma unroll
      for(int k=0;k<4;++k){f[2*k]=__builtin_amdgcn_fmed3f(__uint_as_float(v[k]<<16)*64.f,-448.f,448.f); f[2*k+1]=__builtin_amdgcn_fmed3f(__uint_as_float(v[k]&0xffff0000u)*64.f,-448.f,448.f);}
      u32x2 w8; w8.x=(unsigned)__builtin_amdgcn_cvt_pk_fp8_f32(f[2],f[3],__builtin_amdgcn_cvt_pk_fp8_f32(f[0],f[1],0,false),true); w8.y=(unsigned)__builtin_amdgcn_cvt_pk_fp8_f32(f[6],f[7],__builtin_amdgcn_cvt_pk_fp8_f32(f[4],f[5],0,false),true);
      *(u32x2*)(Ow+(long)row*OP+ch*8)=w8;} }
  asm volatile("s_waitcnt lgkmcnt(0)\n\ts_barrier":::"memory");
  #undef DMA_K
  #undef DMA_V
  #undef CMASK
  #undef START
  #undef RESC
  #undef ROT
}
constexpr int ATTN_LDS_BYTES=LDS_BYTES;
struct AttnTensors { const bf16* Q; const bf16* K; const bf16* V; bf16* O; };
struct AttnUnit { int bh; int qb; };
struct StaticOrder {
  int vcu;
  int G;
  __device__ __forceinline__ explicit StaticOrder(int v,int g):vcu(v),G(g){}
  __device__ __forceinline__ bool next(int i,AttnUnit&u)const{ const int vv=vcu+(i>>4)*G; if(vv>=256)return false; i&=15; const int pair=(vv>>3)+32*(i>>2); const int b=pair>>2,kvh=pair&3; u.bh=b*NHEAD+kvh*4+(vv&3); u.qb=(i&3)+4*((vv>>2)&1); return true; }
  __device__ __forceinline__ void a_ready(const AttnUnit&)const{}
  __device__ __forceinline__ void done(const AttnUnit&)const{}
};
template<class Sched,int THRL=8> __device__ __forceinline__ void attn_phase(char*lds,const AttnTensors&T,const Sched&S,const int wv){
  AttnUnit u;
  for(int i=0;S.next(i,u);++i){ S.a_ready(u); attn_unit<THRL>(u.bh/NHEAD,u.bh%NHEAD,u.qb,T.Q,T.K,T.V,T.O,lds,wv); S.done(u); }
}
#undef SBAR
#undef WAIT_BAR
}

constexpr size_t WS_WIN_T = 1072 * MiB;
constexpr size_t WS_WCAT_T = 1060 * MiB;
constexpr size_t WS_WOUT_T = 1064 * MiB;
constexpr size_t WS_WRS_T = 1066 * MiB + 512 * 1024;
constexpr size_t WS_WSD_T = 1068 * MiB;
constexpr size_t WS_WGU = 144 * MiB;
constexpr size_t WS_WD = 272 * MiB;
constexpr float SC_GR = 8.f, SC_GB = 256.f;
constexpr float SC_ATT = 64.f, SC_WMIX = 256.f, SC_GATED = 32.f;
constexpr float SC_H1 = 16.f, SC_WIN = 256.f;
constexpr float SC_H2 = 16.f, SC_WGU = 256.f, SC_WD = 8.f, SC_ACT = 4.f;
constexpr size_t WS_ACTS = 528 * MiB;
constexpr size_t WS_YT = 560 * MiB;
constexpr float YT_SCALE = 32.f;
constexpr size_t WS_BLKE = 3 * MiB + 64 * 1024;
constexpr int BLK_PER_CH = CH_SLOTS / 256;
constexpr size_t WS_BAR = 64 * 1024;
constexpr int RING_BYTES = 131072, LDSCTL_OFF = RING_BYTES, MISC_OFF = LDSCTL_OFF + 320, LDS_BYTES = 147456;
constexpr int NWAVES = 8;
constexpr int MOE_LDS_OFF = LDSCTL_OFF + 1024;

#define GAS __attribute__((address_space(1)))
#define LAS __attribute__((address_space(3)))
typedef unsigned v4u __attribute__((ext_vector_type(4)));
typedef unsigned v2u __attribute__((ext_vector_type(2)));
typedef float f32x4 __attribute__((ext_vector_type(4)));
#define LDS_WAIT() asm volatile("s_waitcnt lgkmcnt(0)" ::: "memory")
#define VM_WAIT() asm volatile("s_waitcnt vmcnt(0)" ::: "memory")
__device__ __forceinline__ unsigned pk2(float lo, float hi) { return (unsigned)f2bf(lo) | ((unsigned)f2bf(hi) << 16); }

#define XB_TMO      128
#define XB_XCNT(j)  (256  + 64 * (j))
#define XB_XSUB(j)  (1280 + 64 * (j))
#define XB_XGEN(j)  (2304 + 64 * (j))
#define XB_TOP      3328
#define XB_TOPGEN   3392
#define XCD_BAR_WORDS 3456
#define XB_SPIN_CAP (1u << 18)
__device__ __forceinline__ unsigned xb_ld(unsigned* p)              { return __hip_atomic_load(p, __ATOMIC_RELAXED, __HIP_MEMORY_SCOPE_AGENT); }
__device__ __forceinline__ unsigned xb_add(unsigned* p, unsigned v) { return __hip_atomic_fetch_add(p, v, __ATOMIC_RELAXED, __HIP_MEMORY_SCOPE_AGENT); }
__device__ __forceinline__ unsigned xb_xcc_id() { return (unsigned)__builtin_amdgcn_s_getreg((3 << 11) | 20) & 0xFu; }
#define XB_SPIN(cond, bar) do { unsigned _sp = 0; while (cond) { __builtin_amdgcn_s_sleep(1); \
    if ((++_sp & 255u) == 0u) { if (xb_ld(&(bar)[XB_TMO])) break; if (_sp > XB_SPIN_CAP) { atomicAdd(&(bar)[XB_TMO], 1u); break; } } } } while (0)
struct XcdBarrier { unsigned* bar; unsigned x; volatile LAS unsigned* st; int wv; };
__device__ __forceinline__ XcdBarrier xcd_barrier_post(unsigned* bar, volatile LAS unsigned* st, int wv) {
    XcdBarrier b; b.bar = bar; b.x = xb_xcc_id(); b.st = st; b.wv = wv;
    if (threadIdx.x == 0) (void)xb_add(&bar[XB_XCNT(b.x)], 1u);
    return b;
}
__device__ __forceinline__ void xcd_barrier_complete(unsigned* bar, unsigned x, unsigned& nloc, unsigned& nx) {
    const unsigned G = gridDim.x * gridDim.y * gridDim.z;
    unsigned sum, cnt, mine, sp = 0u;
    for (;;) {
        sum = 0u; cnt = 0u; mine = 0u;
#pragma unroll
        for (unsigned j = 0; j < 16; ++j) { const unsigned c = xb_ld(&bar[XB_XCNT(j)]); sum += c; cnt += (c > 0u) ? 1u : 0u; mine = (j == x) ? c : mine; }
        if (sum == G) break;
        __builtin_amdgcn_s_sleep(1);
        if ((++sp & 255u) == 0u) { if (xb_ld(&bar[XB_TMO])) break; if (sp > XB_SPIN_CAP) { atomicAdd(&bar[XB_TMO], 1u); break; } }
    }
    nloc = mine > 0u ? mine : 1u; nx = cnt > 0u ? cnt : 1u;
}
__device__ __forceinline__ void xcd_barrier(const XcdBarrier& b) {
    asm volatile("s_waitcnt vmcnt(0)" ::: "memory");
    __syncthreads();
    if (hw_tid(b.wv) == 0) {
        unsigned* bar = b.bar;
        __builtin_amdgcn_s_waitcnt(0);
        unsigned nloc = b.st[0], nx = b.st[1];
        if (nloc == 0u) { xcd_barrier_complete(bar, b.x, nloc, nx); b.st[0] = nloc; b.st[1] = nx; }
        const unsigned old = xb_add(&bar[XB_XSUB(b.x)], 1u);
        const unsigned gen = old / nloc;
        if (old + 1u == (gen + 1u) * nloc) {
            __builtin_amdgcn_fence(__ATOMIC_RELEASE, "agent");
            asm volatile("s_waitcnt vmcnt(0)" ::: "memory");
            const unsigned og = xb_add(&bar[XB_TOP], 1u);
            const unsigned tg = og / nx;
            if (og + 1u == (tg + 1u) * nx) xb_add(&bar[XB_TOPGEN], 1u);
            else XB_SPIN(xb_ld(&bar[XB_TOPGEN]) == tg, bar);
            __builtin_amdgcn_fence(__ATOMIC_ACQUIRE, "agent");
            xb_add(&bar[XB_XGEN(b.x)], 1u);
            asm volatile("s_waitcnt vmcnt(0)" ::: "memory");
        } else {
            XB_SPIN(xb_ld(&bar[XB_XGEN(b.x)]) == gen, bar);
            __builtin_amdgcn_fence(__ATOMIC_ACQUIRE, "agent");
            asm volatile("s_waitcnt vmcnt(0)" ::: "memory");
        }
    }
    __syncthreads();
}

struct Args { const float* in[22]; float* out; unsigned char* ws; int ph_lo, ph_hi, li, pad; };
enum Phase { PH_PRO = 0, PH_NORM1 = 1, PH_PROJ = 2, PH_ATT = 3, PH_MIX1 = 4, PH_MIX2 = 5, PH_NORM2 = 6, PH_RS = 7, PH_SCAT = 8, PH_EXP0 = 9, PH_COMB0 = 10, PH_END = 11 };

struct Frame {
    LAS unsigned char* lds; volatile LAS unsigned* MISC; unsigned char* ws;
    int tid, lane, wave, vcu, G;
};

template <class RowMap>
__device__ __forceinline__ void p0_transpose_item(const float* W, int K, int N, bf16* WT, int ldt, const RowMap& rm, LAS float* scr, int item, int lane) {
    const int nblk = N / 32, kb = item / nblk, nb = item % nblk, k0 = 64 * kb, n0 = 32 * nb;
#pragma unroll 8
    for (int i = 0; i < 32; ++i) { const int kk = 2 * i + (lane >> 5); scr[kk * 33 + (lane & 31)] = W[(size_t)(k0 + kk) * N + n0 + (lane & 31)]; }
    LDS_WAIT(); asm volatile("" ::: "memory");
    const int c = lane & 7;
#pragma unroll
    for (int j = 0; j < 4; ++j) { const int n = (lane >> 3) + 8 * j; const LAS float* s = scr + (8 * c) * 33 + n;
        v4u o; o.x = pk2(s[0 * 33], s[1 * 33]); o.y = pk2(s[2 * 33], s[3 * 33]); o.z = pk2(s[4 * 33], s[5 * 33]); o.w = pk2(s[6 * 33], s[7 * 33]);
        *(GAS v4u*)(WT + (size_t)rm(n0 + n) * ldt + k0 + 8 * c) = o; }
    LDS_WAIT(); asm volatile("" ::: "memory");
}
__device__ __forceinline__ unsigned pk4_fp8(float a, float b, float c, float d) {
    a = __builtin_amdgcn_fmed3f(a, -448.f, 448.f); b = __builtin_amdgcn_fmed3f(b, -448.f, 448.f); c = __builtin_amdgcn_fmed3f(c, -448.f, 448.f); d = __builtin_amdgcn_fmed3f(d, -448.f, 448.f);
    return (unsigned)__builtin_amdgcn_cvt_pk_fp8_f32(c, d, __builtin_amdgcn_cvt_pk_fp8_f32(a, b, 0, false), true);
}
template <class RowMap>
__device__ __forceinline__ void p0_transpose_item8(const float* W, int K, int N, unsigned char* WT, int ldt, const RowMap& rm, LAS float* scr, int item, int lane, float scale) {
    const int nblk = N / 32, kb = item / nblk, nb = item % nblk, k0 = 64 * kb, n0 = 32 * nb;
#pragma unroll 8
    for (int i = 0; i < 32; ++i) { const int kk = 2 * i + (lane >> 5); scr[kk * 33 + (lane & 31)] = W[(size_t)(k0 + kk) * N + n0 + (lane & 31)] * scale; }
    LDS_WAIT(); asm volatile("" ::: "memory");
    const int c = lane & 3;
#pragma unroll
    for (int j = 0; j < 2; ++j) { const int n = (lane >> 2) + 16 * j; const LAS float* s_ = scr + (16 * c) * 33 + n;
        v4u o; o.x = pk4_fp8(s_[0 * 33], s_[1 * 33], s_[2 * 33], s_[3 * 33]); o.y = pk4_fp8(s_[4 * 33], s_[5 * 33], s_[6 * 33], s_[7 * 33]);
        o.z = pk4_fp8(s_[8 * 33], s_[9 * 33], s_[10 * 33], s_[11 * 33]); o.w = pk4_fp8(s_[12 * 33], s_[13 * 33], s_[14 * 33], s_[15 * 33]);
        *(GAS v4u*)(WT + (size_t)rm(n0 + n) * ldt + k0 + 16 * c) = o; }
    LDS_WAIT(); asm volatile("" ::: "memory");
}
__host__ __device__ __forceinline__ int win_dst_row(int o) {
    if (o >= C_GT) { const int c = o - C_GT, which = c >> 10, col = c & 1023; return C_GT + (col >> 7) * 256 + which * 128 + (col & 127); }
    const bool permuted = (o < C_VA) || (o >= C_QB && o < C_VB);
    if (!permuted) return o;
    const int tile = o & ~255, w = o & 255, wc = w >> 6, dim = w & 63;
    if (o < C_VA) return tile + 128 * (dim >> 5) + 32 * wc + (dim & 31);
    const int half = dim >> 5, dd = dim & 31, bj = (dd >> 4) & 1, u = (dd >> 3) & 1;
    return tile + 128 * bj + 32 * wc + 8 * (2 * half + u) + (dd & 7);
}
struct RmWin { __device__ __forceinline__ int operator()(int n) const { return win_dst_row(n); } };
struct RmSh { int off; __device__ __forceinline__ int operator()(int ff) const { return off + (ff >> 7) * 256 + (ff & 127); } };
struct RmId { int off; __device__ __forceinline__ int operator()(int n) const { return n + off; } };

struct EpiP1 {
    static constexpr bool PERM = true; static constexpr int HOOK_T = -1; static constexpr bool F8 = true;
    static constexpr float DQ = 1.f / (SC_H1 * SC_WIN);
    unsigned char* ws; const float* rope; const float* qn_g; const float* kn_g; const float* b_gate;
    __device__ __forceinline__ void operator()(const pg8::f32x4 (&acc)[2][2][4][2], const pg8::Unit& u, int wr, int wc, int fr, int fq) const {
        using pg8::cvt_pk_bf16; typedef pg8::f32x4 f4;
        const int pn = u.pn; int fr_ = fr, fq_ = fq; asm volatile("" : "+v"(fr_), "+v"(fq_)); const int row0 = u.pm * 256 + wr * 64 + fr_;
        if (pn < 6) {
            const bool isq = pn < 3; bf16* O = (bf16*)(ws + (isq ? WS_QA : WS_KA)); const int hc = (isq ? pn : pn - 3) * 256 + wc * 64 + 8 * fq_; const float sc = (isq ? QSCALE : 1.f) * DQ;
            const float* C1 = rope; const float* S1 = rope + 65536;
#pragma unroll
            for (int ai = 0; ai < 2; ++ai)
#pragma unroll
                for (int m = 0; m < 4; ++m) { const int row = row0 + ai * 128 + m * 16; const int t = row & (SEQ - 1);
                    bf16* op = O + (size_t)row * DILW + hc; pg8::u32x4 w1, w2;
#pragma unroll
                    for (int n = 0; n < 2; ++n) { const f4 c = *(const f4*)(C1 + t * 32 + 8 * fq_ + 4 * n), s = *(const f4*)(S1 + t * 32 + 8 * fq_ + 4 * n);
                        const f4 x1 = acc[ai][0][m][n], x2 = acc[ai][1][m][n]; const f4 o1 = (x1 * c - x2 * s) * sc, o2 = (x2 * c + x1 * s) * sc;
                        w1[2 * n] = cvt_pk_bf16(o1[0], o1[1]); w1[2 * n + 1] = cvt_pk_bf16(o1[2], o1[3]); w2[2 * n] = cvt_pk_bf16(o2[0], o2[1]); w2[2 * n + 1] = cvt_pk_bf16(o2[2], o2[3]); }
                    *(pg8::u32x4*)op = w1; *(pg8::u32x4*)(op + 32) = w2; }
        } else if (pn >= 9 && pn < 14) {
            const bool isq = pn < 13; bf16* O = (bf16*)(ws + (isq ? WS_QB : WS_KB)); const int ld = isq ? GQW : GKW; const int half = fq_ >> 1, u8 = 8 * (fq_ & 1);
            const int hc = (isq ? (pn - 9) * 256 : 0) + wc * 64 + 32 * half + u8;
            const float* g = isq ? qn_g : kn_g; const float sc = isq ? QSCALE : 1.f;
            const float* CR = rope + 131072; const float* SR = CR + 512; const float* CC = SR + 512; const float* SC = CC + 1024;
            f4 gv[2][2]; const int lane_ = (fq_ << 4) | fr_;
#pragma unroll
            for (int bj = 0; bj < 2; ++bj)
#pragma unroll
                for (int n = 0; n < 2; ++n) gv[bj][n] = *(const f4*)(g + 32 * half + u8 + 16 * bj + 4 * n);
#pragma unroll
            for (int ai = 0; ai < 2; ++ai)
#pragma unroll
                for (int m = 0; m < 4; ++m) { const int row = row0 + ai * 128 + m * 16; const int t = row & (SEQ - 1), rp = t >> 6, cp = t & 63;
                    float ss = 0.f;
#pragma unroll
                    for (int bj = 0; bj < 2; ++bj)
#pragma unroll
                        for (int n = 0; n < 2; ++n) { const f4 v = acc[ai][bj][m][n]; ss += (v[0] * v[0] + v[1] * v[1]) + (v[2] * v[2] + v[3] * v[3]); }
                    ss += __builtin_bit_cast(float, __builtin_amdgcn_ds_bpermute(((lane_ ^ 16) << 2), __builtin_bit_cast(int, ss))); ss += __builtin_bit_cast(float, __builtin_amdgcn_ds_bpermute(((lane_ ^ 32) << 2), __builtin_bit_cast(int, ss)));
                    const float rstd = (1.f / sqrtf(ss * (DQ * DQ / 64.f) + NORM_EPS)) * (sc * DQ);
                    bf16* op = O + (size_t)row * ld + hc; pg8::u32x4 w1, w2;
                    const float* ct = half ? (CC + cp * 16 + u8) : (CR + rp * 16 + u8); const float* st = half ? (SC + cp * 16 + u8) : (SR + rp * 16 + u8);
#pragma unroll
                    for (int n = 0; n < 2; ++n) { const f4 c = *(const f4*)(ct + 4 * n), s = *(const f4*)(st + 4 * n);
                        const f4 y1 = acc[ai][0][m][n] * rstd * gv[0][n], y2 = acc[ai][1][m][n] * rstd * gv[1][n]; const f4 o1 = y1 * c - y2 * s, o2 = y2 * c + y1 * s;
                        w1[2 * n] = cvt_pk_bf16(o1[0], o1[1]); w1[2 * n + 1] = cvt_pk_bf16(o1[2], o1[3]); w2[2 * n] = cvt_pk_bf16(o2[0], o2[1]); w2[2 * n + 1] = cvt_pk_bf16(o2[2], o2[3]); }
                    *(pg8::u32x4*)op = w1; *(pg8::u32x4*)(op + 16) = w2; }
        } else if (pn >= 15) {
            bf16* O = (bf16*)(ws + WS_GATES); const int col0 = (pn - 15) * 128 + wc * 32 + 8 * fq_;
            f4 ba[2], bb[2];
#pragma unroll
            for (int n = 0; n < 2; ++n) { ba[n] = *(const f4*)(b_gate + col0 + 4 * n) * -1.44269504f; bb[n] = *(const f4*)(b_gate + 1024 + col0 + 4 * n) * -1.44269504f; }
#pragma unroll
            for (int ai = 0; ai < 2; ++ai)
#pragma unroll
                for (int m = 0; m < 4; ++m) { char* rowp = (char*)O + (size_t)(row0 + ai * 128 + m * 16) * 2048 + col0 * 2; float r[8], g[8];
#pragma unroll
                    for (int n = 0; n < 2; ++n)
#pragma unroll
                        for (int j = 0; j < 4; ++j) { const float ea = 1.f + __builtin_amdgcn_exp2f(__builtin_fmaf(acc[ai][0][m][n][j], -DQ * 1.44269504f, ba[n][j])), eb = 1.f + __builtin_amdgcn_exp2f(__builtin_fmaf(acc[ai][1][m][n][j], -DQ * 1.44269504f, bb[n][j]));
                            g[4 * n + j] = __builtin_amdgcn_rcpf(eb); r[4 * n + j] = eb * __builtin_amdgcn_rcpf(ea); }
                    pg8::u32x4 w_; w_.x = pk4_fp8(r[0] * SC_GR, r[1] * SC_GR, r[2] * SC_GR, r[3] * SC_GR); w_.y = pk4_fp8(r[4] * SC_GR, r[5] * SC_GR, r[6] * SC_GR, r[7] * SC_GR);
                    w_.z = pk4_fp8(g[0] * SC_GB, g[1] * SC_GB, g[2] * SC_GB, g[3] * SC_GB); w_.w = pk4_fp8(g[4] * SC_GB, g[5] * SC_GB, g[6] * SC_GB, g[7] * SC_GB);
                    *(pg8::u32x4*)rowp = w_; }
        } else {
            bf16* O; int ld, cb;
            if (pn < 9) { O = (bf16*)(ws + WS_VA); ld = DILW; cb = (pn - 6) * 256; }
            else { O = (bf16*)(ws + WS_VB); ld = GKW; cb = 0; }
            const int col0 = cb + wc * 32 + 8 * fq_;
#pragma unroll
            for (int ai = 0; ai < 2; ++ai)
#pragma unroll
                for (int m = 0; m < 4; ++m) { bf16* rowp = O + (size_t)(row0 + ai * 128 + m * 16) * ld + col0;
#pragma unroll
                    for (int bj = 0; bj < 2; ++bj) { const f4 v0 = acc[ai][bj][m][0] * DQ, v1 = acc[ai][bj][m][1] * DQ;
                        pg8::u32x4 w; w.x = cvt_pk_bf16(v0[0], v0[1]); w.y = cvt_pk_bf16(v0[2], v0[3]); w.z = cvt_pk_bf16(v1[0], v1[1]); w.w = cvt_pk_bf16(v1[2], v1[3]);
                        *(pg8::u32x4*)(rowp + bj * 128) = w; } }
        }
    }
};

struct EpiGatedF {
    static constexpr bool PERM = true; static constexpr int HOOK_T = 2; static constexpr bool F8 = true;
    const bf16* gates; unsigned char* gated;
    __device__ __forceinline__ void hook(pg8::f32x4 (&acc)[2][2][4][2], const pg8::Unit& u, int wr, int wc, int fr, int fq) const {
        int fr_ = fr, fq_ = fq; asm volatile("" : "+v"(fr_), "+v"(fq_)); const int row0 = u.pm * 256 + wr * 64 + fr_; const int col0 = u.pn * 256 + wc * 32 + 8 * fq_;
        typedef float f2_ __attribute__((ext_vector_type(2)));
        const char* gbase = (const char*)gates; const unsigned goff0 = (unsigned)row0 * 2048u + (unsigned)col0 * 2u;
#pragma unroll
        for (int ai = 0; ai < 2; ++ai) {
#pragma unroll
            for (int m = 0; m < 4; ++m) { const char* gp = gbase + (goff0 + (unsigned)(ai * 128 + m * 16) * 2048u);
#pragma unroll
                for (int bj = 0; bj < 2; ++bj) { const pg8::u32x2 ga = *(const pg8::u32x2*)(gp + bj * 256);
#pragma unroll
                    for (int n = 0; n < 2; ++n) { const f2_ lo = __builtin_amdgcn_cvt_pk_f32_fp8((int)ga[n], false), hi = __builtin_amdgcn_cvt_pk_f32_fp8((int)ga[n], true);
                        acc[ai][bj][m][n][0] *= lo[0] * (1.f / SC_GR); acc[ai][bj][m][n][1] *= lo[1] * (1.f / SC_GR); acc[ai][bj][m][n][2] *= hi[0] * (1.f / SC_GR); acc[ai][bj][m][n][3] *= hi[1] * (1.f / SC_GR); } }
                if (m & 1) asm volatile("" ::: "memory"); }
        }
    }
    __device__ __forceinline__ void operator()(const pg8::f32x4 (&acc)[2][2][4][2], const pg8::Unit& u, int wr, int wc, int fr, int fq) const {
        using pg8::cvt_pk_bf16;
        int fr_ = fr, fq_ = fq; asm volatile("" : "+v"(fr_), "+v"(fq_)); const int row0 = u.pm * 256 + wr * 64 + fr_; const int col0 = u.pn * 256 + wc * 32 + 8 * fq_;
        typedef float f2_ __attribute__((ext_vector_type(2)));
        const char* gbase = (const char*)gates; const unsigned goff0 = (unsigned)row0 * 2048u + (unsigned)col0 * 2u + 8u;
        char* obase = (char*)gated; const unsigned ooff0 = (unsigned)row0 * (unsigned)DM + (unsigned)col0;
        constexpr float OS = SC_GATED / (SC_ATT * SC_WMIX);
#pragma unroll
        for (int ai = 0; ai < 2; ++ai) {
#pragma unroll
            for (int m = 0; m < 4; ++m) {
#pragma unroll
                for (int bj = 0; bj < 2; ++bj) { const pg8::u32x2 gb = *(const pg8::u32x2*)(gbase + (goff0 + (unsigned)(ai * 128 + m * 16) * 2048u + (unsigned)bj * 256u));
                    float v[8];
#pragma unroll
                    for (int n = 0; n < 2; ++n) { const f2_ lo = __builtin_amdgcn_cvt_pk_f32_fp8((int)gb[n], false), hi = __builtin_amdgcn_cvt_pk_f32_fp8((int)gb[n], true);
                        v[4 * n] = acc[ai][bj][m][n][0] * ((OS / SC_GB) * lo[0]); v[4 * n + 1] = acc[ai][bj][m][n][1] * ((OS / SC_GB) * lo[1]); v[4 * n + 2] = acc[ai][bj][m][n][2] * ((OS / SC_GB) * hi[0]); v[4 * n + 3] = acc[ai][bj][m][n][3] * ((OS / SC_GB) * hi[1]); }
                    pg8::u32x2 o; o.x = pk4_fp8(v[0], v[1], v[2], v[3]); o.y = pk4_fp8(v[4], v[5], v[6], v[7]);
                    *(pg8::u32x2*)(obase + (ooff0 + (unsigned)(ai * 128 + m * 16) * 1024u + (unsigned)bj * 128u)) = o; } }
            asm volatile("" ::: "memory");
        }
    }
};
struct EpiXmidF {
    static constexpr bool PERM = true; static constexpr int HOOK_T = -1; static constexpr bool F8 = true; static constexpr float DQ = 1.f / (SC_GATED * SC_WMIX);
    const float* x; const float* mod; bf16* xmid;
    __device__ __forceinline__ void operator()(const pg8::f32x4 (&acc)[2][2][4][2], const pg8::Unit& u, int wr, int wc, int fr, int fq) const {
        using pg8::cvt_pk_bf16; typedef pg8::f32x4 f4;
        int fr_ = fr, fq_ = fq; asm volatile("" : "+v"(fr_), "+v"(fq_)); const int row0 = u.pm * 256 + wr * 64 + fr_; const int col0 = u.pn * 256 + wc * 32 + 8 * fq_; const int b = (u.pm * 256) / SEQ;
        const char* xb = (const char*)x; char* ob = (char*)xmid; const unsigned off0 = (unsigned)row0 * (unsigned)DM + (unsigned)col0;
        f4 gv[2][2];
#pragma unroll
        for (int bj = 0; bj < 2; ++bj)
#pragma unroll
            for (int n = 0; n < 2; ++n) gv[bj][n] = *(const f4*)(mod + (size_t)b * 6144 + 2 * DM + col0 + bj * 128 + 4 * n) * DQ;
#pragma unroll
        for (int ai = 0; ai < 2; ++ai) {
#pragma unroll
            for (int m = 0; m < 4; ++m) { const unsigned off = off0 + (unsigned)(ai * 128 + m * 16) * (unsigned)DM;
#pragma unroll
                for (int bj = 0; bj < 2; ++bj) { const f4 x0 = *(const f4*)(xb + (size_t)(off + bj * 128) * 4), x1 = *(const f4*)(xb + (size_t)(off + bj * 128 + 4) * 4);
                    const f4 v0 = x0 + gv[bj][0] * acc[ai][bj][m][0], v1 = x1 + gv[bj][1] * acc[ai][bj][m][1];
                    pg8::u32x4 o; o.x = cvt_pk_bf16(v0[0], v0[1]); o.y = cvt_pk_bf16(v0[2], v0[3]); o.z = cvt_pk_bf16(v1[0], v1[1]); o.w = cvt_pk_bf16(v1[2], v1[3]);
                    *(pg8::u32x4*)(ob + (size_t)(off + bj * 128) * 2) = o; } }
            asm volatile("" ::: "memory");
        }
    }
};

struct PanelOrder {
    int nP, nN, G, c;
    __device__ void init(int M, int N, int G_, int c_) { nP = M / 256; nN = N / 256; G = G_; c = c_; }
    __device__ bool next(int i, pg8::Unit& u) const { const int p = c + (i / nN) * G; if (p >= nP) return false; u.pm = p; u.pn = i % nN; return true; }
    __device__ __forceinline__ void a_ready(const pg8::Unit&) const {}
    __device__ __forceinline__ void done(const pg8::Unit&) const {}
};
struct EpiRS {
    static constexpr bool PERM = true; static constexpr int HOOK_T = -1;
    float* logits; bf16* shact;
    __device__ __forceinline__ void operator()(const pg8::f32x4 (&acc)[2][2][4][2], const pg8::Unit& u, int wr, int wc, int fr, int fq) const {
        using pg8::cvt_pk_bf16; typedef pg8::f32x4 f4;
        int fr_ = fr, fq_ = fq; asm volatile("" : "+v"(fr_), "+v"(fq_)); const int row0 = u.pm * 256 + wr * 64 + fr_;
        if (u.pn == 0) {
            char* lb = (char*)logits; const unsigned off0 = ((unsigned)row0 * 256u + (unsigned)(wc * 32 + 8 * fq_)) * 4u;
#pragma unroll
            for (int ai = 0; ai < 2; ++ai)
#pragma unroll
                for (int m = 0; m < 4; ++m)
#pragma unroll
                    for (int bj = 0; bj < 2; ++bj)
#pragma unroll
                        for (int n = 0; n < 2; ++n) *(f4*)(lb + (off0 + (unsigned)(ai * 128 + m * 16) * 1024u + (unsigned)(bj * 128 + 4 * n) * 4u)) = acc[ai][bj][m][n];
        } else {
            char* sb = (char*)shact; const unsigned off0 = ((unsigned)row0 * 256u + (unsigned)((u.pn - 1) * 128 + wc * 32 + 8 * fq_)) * 2u;
#pragma unroll
            for (int ai = 0; ai < 2; ++ai)
#pragma unroll
                for (int m = 0; m < 4; ++m) { float v[8];
#pragma unroll
                    for (int n = 0; n < 2; ++n)
#pragma unroll
                        for (int i = 0; i < 4; ++i) { const float g = acc[ai][0][m][n][i], up = acc[ai][1][m][n][i]; v[4 * n + i] = g * __builtin_amdgcn_rcpf(1.f + __expf(-g)) * up; }
                    pg8::u32x4 o; o.x = cvt_pk_bf16(v[0], v[1]); o.y = cvt_pk_bf16(v[2], v[3]); o.z = cvt_pk_bf16(v[4], v[5]); o.w = cvt_pk_bf16(v[6], v[7]);
                    *(pg8::u32x4*)(sb + (off0 + (unsigned)(ai * 128 + m * 16) * 512u)) = o; }
        }
    }
};
struct EpiShDownF {
    static constexpr bool PERM = true; static constexpr int HOOK_T = -1;
    const float* mod; bf16* xo;
    __device__ __forceinline__ void operator()(const pg8::f32x4 (&acc)[2][2][4][2], const pg8::Unit& u, int wr, int wc, int fr, int fq) const {
        using pg8::cvt_pk_bf16; typedef pg8::f32x4 f4;
        int fr_ = fr, fq_ = fq; asm volatile("" : "+v"(fr_), "+v"(fq_)); const int row0 = u.pm * 256 + wr * 64 + fr_; const int col0 = u.pn * 256 + wc * 32 + 8 * fq_; const int b = (u.pm * 256) / SEQ;
        char* ob = (char*)xo; const unsigned off0 = ((unsigned)row0 * (unsigned)DM + (unsigned)col0) * 2u;
        f4 gv[2][2];
#pragma unroll
        for (int bj = 0; bj < 2; ++bj)
#pragma unroll
            for (int n = 0; n < 2; ++n) gv[bj][n] = *(const f4*)(mod + (size_t)b * 6144 + 5 * DM + col0 + bj * 128 + 4 * n);
#pragma unroll
        for (int ai = 0; ai < 2; ++ai) {
#pragma unroll
            for (int m = 0; m < 4; ++m) { const unsigned off = off0 + (unsigned)(ai * 128 + m * 16) * 2048u;
#pragma unroll
                for (int bj = 0; bj < 2; ++bj) { pg8::u32x4* p = (pg8::u32x4*)(ob + (off + (unsigned)bj * 256u)); const pg8::u32x4 w = *p;
                    const f4 v0 = gv[bj][0] * acc[ai][bj][m][0], v1 = gv[bj][1] * acc[ai][bj][m][1];
                    pg8::u32x4 o; o.x = cvt_pk_bf16(__uint_as_float(w.x << 16) + v0[0], __uint_as_float(w.x & 0xffff0000u) + v0[1]); o.y = cvt_pk_bf16(__uint_as_float(w.y << 16) + v0[2], __uint_as_float(w.y & 0xffff0000u) + v0[3]);
                    o.z = cvt_pk_bf16(__uint_as_float(w.z << 16) + v1[0], __uint_as_float(w.z & 0xffff0000u) + v1[1]); o.w = cvt_pk_bf16(__uint_as_float(w.w << 16) + v1[2], __uint_as_float(w.w & 0xffff0000u) + v1[3]);
                    *p = o; } }
            asm volatile("" ::: "memory");
        }
    }
};
__device__ __forceinline__ void topk_row(const float* logits, const float* rbias, int t, int lane, int* IDX, float* GATEV, int* POSE, int* counts) {
    const float4 lg = *(const float4*)(logits + (size_t)t * NEXP + 4 * lane); const float4 rb = *(const float4*)(rbias + 4 * lane);
    float s[4] = {sigmoidf_(lg.x), sigmoidf_(lg.y), sigmoidf_(lg.z), sigmoidf_(lg.w)};
    float v[4] = {s[0] + rb.x, s[1] + rb.y, s[2] + rb.z, s[3] + rb.w};
    float m1 = fmaxf(v[0], v[1]), m2 = fminf(v[0], v[1]);
    { const float a = fmaxf(v[2], v[3]), c = fminf(v[2], v[3]); const float n1 = fmaxf(m1, a); const float n2 = fmaxf(fminf(m1, a), fmaxf(m2, c)); m1 = n1; m2 = n2; }
#pragma unroll
    for (int o = 1; o < 8; o <<= 1) { const float a1 = __shfl_xor(m1, o), a2 = __shfl_xor(m2, o); const float n1 = fmaxf(m1, a1); const float n2 = fmaxf(fminf(m1, a1), fmaxf(m2, a2)); m1 = n1; m2 = n2; }
    const float gs = m1 + m2; const int grp = lane >> 3; int rank = 0;
#pragma unroll
    for (int g2 = 0; g2 < 8; ++g2) { const float o = __shfl(gs, 8 * g2); rank += (o > gs || (o == gs && g2 < grp)) ? 1 : 0; }
    const bool sel = rank < 4;
#pragma unroll
    for (int i = 0; i < 4; ++i) if (!sel) v[i] = -INFINITY;
    int myidx = 0; float mysc = 0.f; float ssum = 0.f;
    for (int k = 0; k < TOPK; ++k) {
        float bv = v[0]; int bi = 4 * lane;
#pragma unroll
        for (int i = 1; i < 4; ++i) if (v[i] > bv) { bv = v[i]; bi = 4 * lane + i; }
#pragma unroll
        for (int o = 1; o < 64; o <<= 1) { const float ov = __shfl_xor(bv, o); const int oi = __shfl_xor(bi, o); if (ov > bv || (ov == bv && oi < bi)) { bv = ov; bi = oi; } }
        const int wl = bi >> 2, wi = bi & 3;
        float sc = 0.f;
        if (lane == wl) {
#pragma unroll
            for (int i = 0; i < 4; ++i) if (i == wi) { sc = s[i]; v[i] = -INFINITY; }
        }
        sc = __shfl(sc, wl); ssum += sc;
        if (lane == k) { myidx = bi; mysc = sc; }
    }
    if (lane < TOPK) {
        const int chunk = t / CH_TOK;
        IDX[(size_t)t * TOPK + lane] = myidx; GATEV[(size_t)t * TOPK + lane] = mysc / ssum * 2.5f;
        POSE[(size_t)t * TOPK + lane] = atomicAdd(&counts[chunk * NEXP + myidx], 1);
    }
}


struct MUnit { const char* A; const char* B; int nt, lda2, ldb2, kind, sub, slot0, restart, gather, mu; };
__device__ __forceinline__ int ld_agent(const int* p) { return __hip_atomic_load(p, __ATOMIC_RELAXED, __HIP_MEMORY_SCOPE_AGENT); }
constexpr int MOE_MAXMU = 16;
struct MoeOrder {
    int c, G, w; const LAS int* blk; const char* H2; const char* WGU; const char* WD; const char* acts;
    __device__ __forceinline__ bool next(int i, MUnit& u) const {
        const int mu = i / 6, j = i - mu * 6; const int g = w + mu * G; if (g >= BLK_PER_CH || mu >= MOE_MAXMU) return false;
        const int e = __builtin_amdgcn_readfirstlane(blk[mu]); if (e < 0) return false;
        u.slot0 = c * CH_SLOTS + 256 * g; u.mu = mu;
        if (j < 2) { u.kind = 0; u.sub = j; u.A = H2; u.B = WGU + ((size_t)e * 512 + (size_t)j * 256) * 1024; u.nt = 8; u.lda2 = 1024; u.ldb2 = 1024; u.gather = 1; u.restart = 0; }
        else { u.kind = 1; u.sub = j - 2; u.A = acts; u.B = WD + ((size_t)e * 1024 + (size_t)(j - 2) * 256) * 256; u.nt = 2; u.lda2 = 256; u.ldb2 = 256; u.gather = 0; u.restart = (j == 2) ? 1 : 0; }
        return true;
    }
};
template <class E1, class E2>
__device__ __forceinline__ void gemm_phase_moe(PG8_LAS unsigned char* lds, const MoeOrder& S, const E1& e1, const E2& e2, const int* stok, const float* sgate, PG8_LAS int* tcode, PG8_LAS float* tgate, const int wv) {
    using namespace pg8;
    int tid = hw_tid(wv);
    const int wid = __builtin_amdgcn_readfirstlane(tid >> 6), lane = tid & 63, wr = wid >> 2, wc = wid & 3, fr = lane & 15, fq = lane >> 4;
    const size_t kstep = (size_t)(BK * 2);
    const unsigned ldsw = (unsigned)wid * 1024u;
    const int aoff = lds_byte(wr * 64 + fr, fq * 8), boff = lds_byte(wc * 32 + fr, fq * 8);
#define PG8_SA(b, h) (((b) * 2 + (h)) * HTB)
#define PG8_SB(b, h) ((4 + (b) * 2 + (h)) * HTB)
#define PG8_STAGE(bufoff, gbase, voff) do { _Pragma("unroll") for (int _i = 0; _i < 2; ++_i) { unsigned o_ = (voff)[_i]; asm volatile("" : "+v"(o_));   \
        __builtin_amdgcn_global_load_lds((const unsigned*)((const char*)(gbase) + o_), (PG8_LAS unsigned*)(lds + (bufoff) + ldsw + _i * 8192), 16, 0, 0); } } while (0)
#define PG8_LDA(dst, b, h) do { _Pragma("unroll") for (int m = 0; m < 4; ++m) _Pragma("unroll") for (int k = 0; k < 2; ++k) dst[m][k] = *(const PG8_LAS bf16x8*)(lds + PG8_SA(b, h) + aoff + m * 2048 + k * 1024); } while (0)
#define PG8_LDB(dst, b, h) do { _Pragma("unroll") for (int n = 0; n < 2; ++n) _Pragma("unroll") for (int k = 0; k < 2; ++k) dst[n][k] = *(const PG8_LAS bf16x8*)(lds + PG8_SB(b, h) + boff + n * 2048 + k * 1024); } while (0)
    typedef int i32x8_t __attribute__((ext_vector_type(8))); typedef int i32x4_t __attribute__((ext_vector_type(4)));
#define PG8_CAT(lo, hi) __builtin_shufflevector(__builtin_bit_cast(i32x4_t, lo), __builtin_bit_cast(i32x4_t, hi), 0, 1, 2, 3, 4, 5, 6, 7)
#define PG8_MMA(ai, bj, At, Bt) do { _Pragma("unroll") for (int m = 0; m < 4; ++m) _Pragma("unroll") for (int n = 0; n < 2; ++n) \
        acc[ai][bj][m][n] = __builtin_amdgcn_mfma_scale_f32_16x16x128_f8f6f4(PG8_CAT(Bt[n][0], Bt[n][1]), PG8_CAT(At[m][0], At[m][1]), acc[ai][bj][m][n], 0, 0, 0, 0x7F7F7F7F, 0, 0x7F7F7F7F); \
        } while (0)
#define PG8_WAIT_V(n) asm volatile("s_waitcnt vmcnt(" #n ")" ::: "memory")
#define PG8_WAIT_VF(f) asm volatile("s_cmp_lg_u32 %0, 0\n\ts_cbranch_scc1 1f\n\ts_waitcnt vmcnt(8)\n1:\n\ts_waitcnt vmcnt(16)" :: "s"((int)(f)) : "memory", "scc")
#define PG8_STAGE_UNLESS(f, bufoff, gbase, voff) do { unsigned keep_; \
        asm volatile("s_cmp_lg_u32 %5, 0\n\ts_cbranch_scc1 1f\n\ts_mov_b32 %0, m0\n\ts_mov_b32 m0, %3\n\ts_nop 0\n\tglobal_load_lds_dwordx4 %1, %6\n\ts_mov_b32 m0, %4\n\ts_nop 0\n\tglobal_load_lds_dwordx4 %2, %6\n\ts_mov_b32 m0, %0\n1:" \
                     : "=&s"(keep_) : "v"((voff)[0]), "v"((voff)[1]), "s"((unsigned)(size_t)(lds + (bufoff) + ldsw)), "s"((unsigned)(size_t)(lds + (bufoff) + ldsw + 8192)), "s"((int)(f)), "s"(gbase) : "memory", "scc"); } while (0)
#define PG8_WAIT_L(n) asm volatile("s_waitcnt lgkmcnt(" #n ")" ::: "memory")
#define PG8_BAR __builtin_amdgcn_s_barrier()
#define PG8_SCHED __builtin_amdgcn_sched_barrier(0)
#define MOE_GEOM() int gR[2], gC2[2], gRb[2]; { int t_ = tid; asm volatile("" : "+v"(t_)); _Pragma("unroll") for (int _i = 0; _i < 2; ++_i) { int R_, C_; stage_rc(t_ * 16 + _i * 8192, R_, C_); gR[_i] = R_; gC2[_i] = C_ * 2; gRb[_i] = (R_ & ~31) + perm32(R_ & 31); } }
#define MOE_OFFS(vA_, vB_, hB_, u, use_tok, keepA) do { MOE_GEOM(); \
        if (!(keepA)) { if (use_tok) { _Pragma("unroll") for (int _h = 0; _h < 2; ++_h) _Pragma("unroll") for (int _i = 0; _i < 2; ++_i) { const int _t = tcode[((u).mu & 1) * 256 + _h * 128 + gR[_i]] >> 3; vA_[_h][_i] = (unsigned)(_t < 0 ? 0 : _t) * 1024u + (unsigned)gC2[_i]; } } \
                        else { _Pragma("unroll") for (int _h = 0; _h < 2; ++_h) _Pragma("unroll") for (int _i = 0; _i < 2; ++_i) vA_[_h][_i] = (unsigned)((gR[_i] + 128 * _h) * (u).lda2 + gC2[_i]); } } \
          \
        if ((u).kind == 1) { _Pragma("unroll") for (int _i = 0; _i < 2; ++_i) { const int l_ = gRb[_i] & 31; vB_[_i] = (unsigned)((2 * (gRb[_i] & ~31) + ((l_ & 24) << 1) + (l_ & 7)) * (u).ldb2 + gC2[_i]); } hB_ = (size_t)8 * (size_t)(u).ldb2; } \
        else { _Pragma("unroll") for (int _i = 0; _i < 2; ++_i) vB_[_i] = (unsigned)(gRb[_i] * (u).ldb2 + gC2[_i]); hB_ = (size_t)128 * (size_t)(u).ldb2; } } while (0)
    MUnit cur, nxt; int ui = 0;
    if (!S.next(0, cur)) return;
    if (tid < 256) { tcode[tid] = stok[cur.slot0 + tid]; tgate[tid] = sgate[cur.slot0 + tid]; }
    asm volatile("s_waitcnt vmcnt(0) lgkmcnt(0)" ::: "memory"); __builtin_amdgcn_s_barrier(); asm volatile("" ::: "memory");
    f32x4 acc[2][2][4][2];
#pragma unroll
    for (int a = 0; a < 2; ++a)
#pragma unroll
        for (int b = 0; b < 2; ++b)
#pragma unroll
            for (int m = 0; m < 4; ++m)
#pragma unroll
                for (int n = 0; n < 2; ++n) acc[a][b][m][n] = (f32x4){0.f, 0.f, 0.f, 0.f};
    bf16x8 At[4][2], B0[2][2], B1[2][2];
    unsigned vA[2][2], vB[2]; size_t hB;
    MOE_OFFS(vA, vB, hB, cur, cur.gather, false);
    bool fresh = true, post = false;
    for (;;) {
        const char* cA = cur.A; const char* cB = cur.B;
        if (fresh) {
            PG8_STAGE(PG8_SB(0, 0), cB, vB); PG8_STAGE(PG8_SB(0, 1), cB + hB, vB); PG8_STAGE(PG8_SA(0, 0), cA, vA[0]); PG8_STAGE(PG8_SA(0, 1), cA, vA[1]);
            if (wr == 1) PG8_BAR;
            PG8_WAIT_V(2); PG8_BAR;
            PG8_STAGE(PG8_SB(1, 0), cB + kstep, vB); PG8_STAGE(PG8_SA(1, 0), cA + kstep, vA[0]); PG8_STAGE(PG8_SB(1, 1), cB + hB + kstep, vB);
            PG8_WAIT_V(6); PG8_BAR;
            fresh = false;
        }
        const bool has_next = S.next(ui + 1, nxt);
        const bool chain = has_next && !nxt.restart;
        const bool same_rows = chain && nxt.gather && cur.gather && nxt.slot0 == cur.slot0;
        const bool need_tok = chain && nxt.gather && !same_rows;
        const bool pf = (cur.kind == 1 && cur.sub == 2);
        if (pf && wid < 4) {
            const int s1 = cur.slot0 + S.G * 256; const bool ok = (S.w + (cur.mu + 1) * S.G) < BLK_PER_CH;
            PG8_LAS int* dc = tcode + ((cur.mu + 1) & 1) * 256 + wid * 64; PG8_LAS float* dg = tgate + ((cur.mu + 1) & 1) * 256 + wid * 64;
            int t_ = tid; asm volatile("" : "+v"(t_));
            if (ok) { __builtin_amdgcn_global_load_lds((const unsigned*)(stok + s1) + t_, (PG8_LAS unsigned*)dc, 4, 0, 0); __builtin_amdgcn_global_load_lds((const unsigned*)(sgate + s1) + t_, (PG8_LAS unsigned*)dg, 4, 0, 0); }
            else { dc[t_ & 63] = -1; dg[t_ & 63] = 0.f; }
        }
        const char* nA = chain ? nxt.A : cA; const char* nB = chain ? nxt.B : cB;
        const int nt = cur.nt;
#pragma nounroll
        for (int t = 0; t < nt; t += 2) {
            const bool last = (t == nt - 2);
            const char* a1 = cA + (size_t)(t + 1) * kstep;
            const char* a2 = last ? nA : cA + (size_t)(t + 2) * kstep; const char* b2 = last ? nB : cB + (size_t)(t + 2) * kstep;
            const char* a3 = a2 + kstep; const char* b3 = b2 + kstep;
            const int first = __builtin_amdgcn_readfirstlane((int)(post && t == 0));
            PG8_LDB(B0, 0, 0); PG8_LDB(B1, 0, 1); PG8_SCHED; PG8_LDA(At, 0, 0); PG8_STAGE_UNLESS(first, PG8_SA(1, 1), a1, vA[1]);
            PG8_WAIT_VF(first); PG8_WAIT_L(0); PG8_BAR; PG8_MMA(0, 0, At, B0); PG8_MMA(0, 1, At, B1);
            if (last && chain) MOE_OFFS(vA, vB, hB, nxt, need_tok, same_rows);
            PG8_BAR; PG8_SCHED;
            PG8_LDA(At, 0, 1); PG8_STAGE(PG8_SB(0, 0), b2, vB); PG8_STAGE(PG8_SB(0, 1), b2 + hB, vB); PG8_STAGE(PG8_SA(0, 0), a2, vA[0]);
            PG8_WAIT_VF(first); PG8_WAIT_L(0); PG8_BAR; PG8_MMA(1, 0, At, B0); PG8_MMA(1, 1, At, B1); PG8_BAR; PG8_SCHED;
            PG8_LDB(B0, 1, 0); PG8_LDB(B1, 1, 1); PG8_SCHED; PG8_LDA(At, 1, 0); PG8_STAGE(PG8_SA(0, 1), a2, vA[1]);
            PG8_WAIT_VF(first); PG8_WAIT_L(0); PG8_BAR; PG8_MMA(0, 0, At, B0); PG8_MMA(0, 1, At, B1); PG8_BAR; PG8_SCHED;
            PG8_LDA(At, 1, 1); PG8_STAGE(PG8_SB(1, 0), b3, vB); PG8_STAGE(PG8_SB(1, 1), b3 + hB, vB); PG8_STAGE(PG8_SA(1, 0), a3, vA[0]);
            PG8_WAIT_V(8); PG8_WAIT_L(0); PG8_BAR; PG8_MMA(1, 0, At, B0); PG8_MMA(1, 1, At, B1); PG8_BAR; PG8_SCHED;
        }
        if (wr == 0) PG8_BAR;
        if (chain) PG8_STAGE(PG8_SA(1, 1), nA + kstep, vA[1]);
        { int t_ = tid; asm volatile("" : "+v"(t_)); const int fr_ = t_ & 15, fq_ = (t_ >> 4) & 3;
          if (cur.kind == 0) e1(acc, cur, wr, wc, fr_, fq_); else e2(acc, cur, wr, wc, fr_, fq_); }
        if (!has_next) break;
#pragma unroll
        for (int a = 0; a < 2; ++a)
#pragma unroll
            for (int b = 0; b < 2; ++b)
#pragma unroll
                for (int m = 0; m < 4; ++m)
#pragma unroll
                    for (int n = 0; n < 2; ++n) acc[a][b][m][n] = (f32x4){0.f, 0.f, 0.f, 0.f};
        ++ui;
        post = chain;
        if (chain) { cur = nxt; if (wr == 1) PG8_BAR; }
        else {
            PG8_WAIT_V(0); PG8_BAR;
            cur = nxt;
            MOE_OFFS(vA, vB, hB, cur, cur.gather, false);
            fresh = true;
        }
    }
    PG8_WAIT_V(0);
    PG8_BAR;
#undef MOE_GEOM
#undef PG8_WAIT_VF
#undef PG8_STAGE_UNLESS
#undef MOE_OFFS
#undef PG8_SA
#undef PG8_SB
#undef PG8_STAGE
#undef PG8_LDA
#undef PG8_LDB
#undef PG8_MMA
#undef PG8_CAT
#undef PG8_WAIT_V
#undef PG8_WAIT_L
#undef PG8_BAR
#undef PG8_SCHED
}
struct EpiT1 {
    const LAS float* tgate; char* acts;
    __device__ __forceinline__ void operator()(const pg8::f32x4 (&acc)[2][2][4][2], const MUnit& u, int wr, int wc, int fr, int fq) const {
        int fr_ = fr, fq_ = fq; asm volatile("" : "+v"(fr_), "+v"(fq_)); const int r0 = wr * 64 + fr_;
        const unsigned off0 = (unsigned)r0 * 256u + (unsigned)(u.sub * 128 + wc * 32 + 8 * fq_);
        constexpr float IS = 1.f / (SC_H2 * SC_WGU);
#pragma unroll
        for (int ai = 0; ai < 2; ++ai)
#pragma unroll
            for (int m = 0; m < 4; ++m) { const float gw2 = tgate[(u.mu & 1) * 256 + r0 + ai * 128 + m * 16] * (SC_ACT * IS * IS); float v[8];
#pragma unroll
                for (int n = 0; n < 2; ++n)
#pragma unroll
                    for (int i = 0; i < 4; ++i) { const float ag = acc[ai][0][m][n][i], au = acc[ai][1][m][n][i];
                        v[4 * n + i] = (ag * au) * gw2 * __builtin_amdgcn_rcpf(1.f + __builtin_amdgcn_exp2f(ag * (-IS * 1.44269504f))); }
                v2u o; o.x = pk4_fp8(v[0], v[1], v[2], v[3]); o.y = pk4_fp8(v[4], v[5], v[6], v[7]);
                *(v2u*)(acts + (off0 + (unsigned)(ai * 128 + m * 16) * 256u)) = o; }
    }
};
constexpr int MOE_NST = 8;
struct EpiT2 {
    const LAS int* tcode; char* yt; int code0;
    __device__ __forceinline__ void operator()(const pg8::f32x4 (&acc)[2][2][4][2], const MUnit& u, int wr, int wc, int fr, int fq) const {
        int fr_ = fr, fq_ = fq; asm volatile("" : "+v"(fr_), "+v"(fq_)); const int r0 = wr * 64 + fr_;
        const unsigned colb = (unsigned)(u.sub * 256 + wc * 64 + 16 * fq_);
#pragma unroll
        for (int ai = 0; ai < 2; ++ai)
#pragma unroll
            for (int m = 0; m < 4; ++m) { const int code = tcode[(u.mu & 1) * 256 + r0 + ai * 128 + m * 16];
                char* rowp = yt + (size_t)(unsigned)(code >= 0 ? code - code0 : CH_TOK * TOPK) * 1024u + colb; v4u o;
#pragma unroll
                for (int bj = 0; bj < 2; ++bj) { static_assert(YT_SCALE == SC_ACT * SC_WD, "scales"); pg8::f32x4 v0 = acc[ai][bj][m][0], v1 = acc[ai][bj][m][1];
#pragma unroll
                    for (int j = 0; j < 4; ++j) { v0[j] = __builtin_amdgcn_fmed3f(v0[j], -448.f, 448.f); v1[j] = __builtin_amdgcn_fmed3f(v1[j], -448.f, 448.f); }
                    const unsigned lo = (unsigned)__builtin_amdgcn_cvt_pk_fp8_f32(v0[2], v0[3], __builtin_amdgcn_cvt_pk_fp8_f32(v0[0], v0[1], 0, false), true);
                    const unsigned hi = (unsigned)__builtin_amdgcn_cvt_pk_fp8_f32(v1[2], v1[3], __builtin_amdgcn_cvt_pk_fp8_f32(v1[0], v1[1], 0, false), true);
                    if (bj == 0) { o.x = lo; o.y = hi; } else { o.z = lo; o.w = hi; } }
                *(v4u*)rowp = o; }
    }
};
__device__ __forceinline__ void combine_row(const bf16* xm, float* orow, const char* yt_tok, const float* gate2, const float* fg, int lane) {
    typedef float f2 __attribute__((ext_vector_type(2)));
    float x[16], a[16];
#pragma unroll
    for (int h = 0; h < 2; ++h) { const v4u w = *(const v4u*)(xm + 16 * lane + 8 * h);
        x[8 * h + 0] = __uint_as_float(w.x << 16); x[8 * h + 1] = __uint_as_float(w.x & 0xffff0000u); x[8 * h + 2] = __uint_as_float(w.y << 16); x[8 * h + 3] = __uint_as_float(w.y & 0xffff0000u);
        x[8 * h + 4] = __uint_as_float(w.z << 16); x[8 * h + 5] = __uint_as_float(w.z & 0xffff0000u); x[8 * h + 6] = __uint_as_float(w.w << 16); x[8 * h + 7] = __uint_as_float(w.w & 0xffff0000u); }
#pragma unroll
    for (int j = 0; j < 16; ++j) a[j] = 0.f;
#pragma unroll
    for (int k = 0; k < TOPK; ++k) { const v4u w = *(const v4u*)(yt_tok + (size_t)k * 1024 + 16 * lane);
#pragma unroll
        for (int q = 0; q < 4; ++q) { const f2 lo = __builtin_amdgcn_cvt_pk_f32_fp8((int)w[q], false), hi = __builtin_amdgcn_cvt_pk_f32_fp8((int)w[q], true);
            a[4 * q + 0] += lo[0]; a[4 * q + 1] += lo[1]; a[4 * q + 2] += hi[0]; a[4 * q + 3] += hi[1]; } }
    float ss = 0.f;
#pragma unroll
    for (int q = 0; q < 4; ++q) { const f32x4 g2 = *(const f32x4*)(gate2 + 16 * lane + 4 * q);
#pragma unroll
        for (int j = 0; j < 4; ++j) { x[4 * q + j] += g2[j] * a[4 * q + j] * (1.f / YT_SCALE); ss += x[4 * q + j] * x[4 * q + j]; } }
    const float rstd = 1.f / sqrtf(wave_sum(ss) * (1.f / DM) + NORM_EPS);
#pragma unroll
    for (int q = 0; q < 4; ++q) { const f32x4 g = *(const f32x4*)(fg + 16 * lane + 4 * q);
        *(f32x4*)(orow + 16 * lane + 4 * q) = (f32x4){x[4 * q] * rstd * g[0], x[4 * q + 1] * rstd * g[1], x[4 * q + 2] * rstd * g[2], x[4 * q + 3] * rstd * g[3]}; }
}
__device__ __forceinline__ void combine_row_r(const bf16* xm, float* orow, const char* yt_tok, const f32x4 (&g2v)[4], const f32x4 (&fgv)[4], int lane) {
    typedef float f2 __attribute__((ext_vector_type(2)));
    float x[16], a[16];
#pragma unroll
    for (int h = 0; h < 2; ++h) { const v4u w = *(const v4u*)(xm + 16 * lane + 8 * h);
        x[8 * h + 0] = __uint_as_float(w.x << 16); x[8 * h + 1] = __uint_as_float(w.x & 0xffff0000u); x[8 * h + 2] = __uint_as_float(w.y << 16); x[8 * h + 3] = __uint_as_float(w.y & 0xffff0000u);
        x[8 * h + 4] = __uint_as_float(w.z << 16); x[8 * h + 5] = __uint_as_float(w.z & 0xffff0000u); x[8 * h + 6] = __uint_as_float(w.w << 16); x[8 * h + 7] = __uint_as_float(w.w & 0xffff0000u); }
#pragma unroll
    for (int j = 0; j < 16; ++j) a[j] = 0.f;
#pragma unroll
    for (int k = 0; k < TOPK; ++k) { const v4u w = *(const v4u*)(yt_tok + (size_t)k * 1024 + 16 * lane);
#pragma unroll
        for (int q = 0; q < 4; ++q) { const f2 lo = __builtin_amdgcn_cvt_pk_f32_fp8((int)w[q], false), hi = __builtin_amdgcn_cvt_pk_f32_fp8((int)w[q], true);
            a[4 * q + 0] += lo[0]; a[4 * q + 1] += lo[1]; a[4 * q + 2] += hi[0]; a[4 * q + 3] += hi[1]; } }
    float ss = 0.f;
#pragma unroll
    for (int q = 0; q < 4; ++q) {
#pragma unroll
        for (int j = 0; j < 4; ++j) { x[4 * q + j] += g2v[q][j] * a[4 * q + j]; ss += x[4 * q + j] * x[4 * q + j]; } }
    const float rstd = 1.f / sqrtf(wave_sum(ss) * (1.f / DM) + NORM_EPS);
#pragma unroll
    for (int q = 0; q < 4; ++q) { const f32x4 g = fgv[q];
        *(f32x4*)(orow + 16 * lane + 4 * q) = (f32x4){x[4 * q] * rstd * g[0], x[4 * q + 1] * rstd * g[1], x[4 * q + 2] * rstd * g[2], x[4 * q + 3] * rstd * g[3]}; }
}


__device__ __forceinline__ void dil_simple_item(const bf16* QA, const bf16* KA, const bf16* VA, bf16* ATT, int b, int hh, int t) {
    const size_t row = (size_t)b * SEQ + t;
    float q[64], o[64];
#pragma unroll
    for (int d = 0; d < 64; ++d) o[d] = 0.f;
    float m = -1e30f, l = 0.f;
    for (int g = 0; g < 3; ++g) {
        const int dil = (g == 0) ? 1 : (g == 1) ? 4 : 16; const int hc = (g * 4 + hh) * 64;
#pragma unroll
        for (int d8 = 0; d8 < 8; ++d8) { const v4u w = *(const v4u*)(QA + row * DILW + hc + 8 * d8);
            q[8 * d8 + 0] = __uint_as_float(w.x << 16); q[8 * d8 + 1] = __uint_as_float(w.x & 0xffff0000u); q[8 * d8 + 2] = __uint_as_float(w.y << 16); q[8 * d8 + 3] = __uint_as_float(w.y & 0xffff0000u);
            q[8 * d8 + 4] = __uint_as_float(w.z << 16); q[8 * d8 + 5] = __uint_as_float(w.z & 0xffff0000u); q[8 * d8 + 6] = __uint_as_float(w.w << 16); q[8 * d8 + 7] = __uint_as_float(w.w & 0xffff0000u); }
        for (int j = -64; j <= 64; ++j) {
            const int t2 = t + j * dil; if (t2 < 0 || t2 >= SEQ) continue;
            const bf16* kr = KA + ((size_t)b * SEQ + t2) * DILW + hc; const bf16* vr = VA + ((size_t)b * SEQ + t2) * DILW + hc;
            float s = 0.f;
#pragma unroll
            for (int d8 = 0; d8 < 8; ++d8) { const v4u w = *(const v4u*)(kr + 8 * d8);
                s += q[8 * d8 + 0] * __uint_as_float(w.x << 16) + q[8 * d8 + 1] * __uint_as_float(w.x & 0xffff0000u) + q[8 * d8 + 2] * __uint_as_float(w.y << 16) + q[8 * d8 + 3] * __uint_as_float(w.y & 0xffff0000u)
                   + q[8 * d8 + 4] * __uint_as_float(w.z << 16) + q[8 * d8 + 5] * __uint_as_float(w.z & 0xffff0000u) + q[8 * d8 + 6] * __uint_as_float(w.w << 16) + q[8 * d8 + 7] * __uint_as_float(w.w & 0xffff0000u); }
            const float mn = fmaxf(m, s), corr = exp2f(m - mn), p = exp2f(s - mn);
            l = l * corr + p; m = mn;
#pragma unroll
            for (int d8 = 0; d8 < 8; ++d8) { const v4u w = *(const v4u*)(vr + 8 * d8);
                o[8 * d8 + 0] = o[8 * d8 + 0] * corr + p * __uint_as_float(w.x << 16); o[8 * d8 + 1] = o[8 * d8 + 1] * corr + p * __uint_as_float(w.x & 0xffff0000u);
                o[8 * d8 + 2] = o[8 * d8 + 2] * corr + p * __uint_as_float(w.y << 16); o[8 * d8 + 3] = o[8 * d8 + 3] * corr + p * __uint_as_float(w.y & 0xffff0000u);
                o[8 * d8 + 4] = o[8 * d8 + 4] * corr + p * __uint_as_float(w.z << 16); o[8 * d8 + 5] = o[8 * d8 + 5] * corr + p * __uint_as_float(w.z & 0xffff0000u);
                o[8 * d8 + 6] = o[8 * d8 + 6] * corr + p * __uint_as_float(w.w << 16); o[8 * d8 + 7] = o[8 * d8 + 7] * corr + p * __uint_as_float(w.w & 0xffff0000u); }
        }
    }
    const float il = 1.f / l;
#pragma unroll
    for (int d8 = 0; d8 < 8; ++d8) { v4u w; w.x = pk2(o[8 * d8] * il, o[8 * d8 + 1] * il); w.y = pk2(o[8 * d8 + 2] * il, o[8 * d8 + 3] * il); w.z = pk2(o[8 * d8 + 4] * il, o[8 * d8 + 5] * il); w.w = pk2(o[8 * d8 + 6] * il, o[8 * d8 + 7] * il);
        *(v4u*)(ATT + row * 1280 + hh * 64 + 8 * d8) = w; }
}


constexpr size_t WS_OG = 912 * MiB;
constexpr size_t WS_LSE = 1008 * MiB;
typedef float f32x16 __attribute__((ext_vector_type(16)));
typedef short s16x4v __attribute__((ext_vector_type(4)));
__device__ __forceinline__ void dil_tile(const bf16* QA, const bf16* KA, const bf16* VA, bf16* OG, float* LSE, LAS unsigned char* vl, int b, int g, int hh, int r, int ub, int lane) {
    asm volatile("" : "+v"(lane));
    const int dil = (g == 0) ? 1 : (g == 1) ? 4 : 16, L = SEQ / dil, hc = (g * 4 + hh) * 64;
    const int r32 = lane & 31, hi = lane >> 5;
    const size_t rowb = (size_t)b * SEQ;
    const int tq = (32 * ub + r32) * dil + r;
    pg8::bf16x8 qf[4];
    { LAS unsigned char* slot = vl + 4608;
#pragma unroll
      for (int i = 0; i < 4; ++i) { const int id = i * 64 + lane, row = id >> 3, ch = id & 7;
          const v4u w = *(const v4u*)(QA + (rowb + (size_t)((32 * ub + row) * dil + r)) * DILW + hc + 8 * ch); *(LAS v4u*)(slot + row * 144 + ch * 16) = w; }
#pragma unroll
      for (int d0 = 0; d0 < 4; ++d0) qf[d0] = *(const LAS pg8::bf16x8*)(slot + r32 * 144 + (16 * d0 + 8 * hi) * 2); }
    f32x16 sc[5];
#pragma unroll
    for (int kvb = 0; kvb < 5; ++kvb) {
        LAS unsigned char* slot = vl + (kvb & 1) * 4608;
#pragma unroll
        for (int i = 0; i < 4; ++i) { const int id = i * 64 + lane, row = id >> 3, ch = id & 7; int uk = 32 * ub - 64 + 32 * kvb + row; uk = uk < 0 ? 0 : (uk > L - 1 ? L - 1 : uk);
            const v4u w = *(const v4u*)(KA + (rowb + (size_t)(uk * dil + r)) * DILW + hc + 8 * ch); *(LAS v4u*)(slot + row * 144 + ch * 16) = w; }
        f32x16 a = {};
#pragma unroll
        for (int d0 = 0; d0 < 4; ++d0) { const pg8::bf16x8 kf = *(const LAS pg8::bf16x8*)(slot + r32 * 144 + (16 * d0 + 8 * hi) * 2); a = __builtin_amdgcn_mfma_f32_32x32x16_bf16(kf, qf[d0], a, 0, 0, 0); }
        sc[kvb] = a;
    }
    float m = -INFINITY;
#pragma unroll
    for (int kvb = 0; kvb < 5; ++kvb)
#pragma unroll
        for (int rg = 0; rg < 16; ++rg) { const int kvl = (rg & 3) + 8 * (rg >> 2) + 4 * hi; const int du = -64 + 32 * kvb + kvl - r32; const int uu = 32 * ub + r32 + du;
            const bool ok = (du >= -64) && (du <= 64) && (uu >= 0) && (uu < L); const float v = ok ? sc[kvb][rg] : -INFINITY; sc[kvb][rg] = v; m = fmaxf(m, v); }
    m = fmaxf(m, __shfl_xor(m, 32));
    float l = 0.f;
#pragma unroll
    for (int kvb = 0; kvb < 5; ++kvb)
#pragma unroll
        for (int rg = 0; rg < 16; ++rg) { const float p = exp2f(sc[kvb][rg] - m); sc[kvb][rg] = p; l += p; }
    l += __shfl_xor(l, 32);
    f32x16 o0 = {}, o1 = {};
    const int g16 = lane >> 4, chalf = g16 & 1, q4 = (lane & 15) >> 2, p4 = lane & 3;
#pragma unroll
    for (int kvb = 0; kvb < 5; ++kvb) {
        LAS unsigned char* slot = vl + (kvb & 1) * 4608;
#pragma unroll
        for (int i = 0; i < 4; ++i) { const int id = i * 64 + lane, row = id >> 3, ch = id & 7; int uv = 32 * ub - 64 + 32 * kvb + row; uv = uv < 0 ? 0 : (uv > L - 1 ? L - 1 : uv);
            const v4u w = *(const v4u*)(VA + (rowb + (size_t)(uv * dil + r)) * DILW + hc + 8 * ch); *(LAS v4u*)(slot + row * 144 + ch * 16) = w; }
#pragma unroll
        for (int st = 0; st < 2; ++st) {
            pg8::u32x4 pw; pw.x = pg8::cvt_pk_bf16(sc[kvb][8 * st + 0], sc[kvb][8 * st + 1]); pw.y = pg8::cvt_pk_bf16(sc[kvb][8 * st + 2], sc[kvb][8 * st + 3]);
            pw.z = pg8::cvt_pk_bf16(sc[kvb][8 * st + 4], sc[kvb][8 * st + 5]); pw.w = pg8::cvt_pk_bf16(sc[kvb][8 * st + 6], sc[kvb][8 * st + 7]);
            const pg8::bf16x8 pa = __builtin_bit_cast(pg8::bf16x8, pw);
#pragma unroll
            for (int dh = 0; dh < 2; ++dh) {
                LAS unsigned char* ap = slot + (16 * st + 4 * hi + q4) * 144 + (32 * dh + 16 * chalf + 4 * p4) * 2;
                const s16x4v lo = __builtin_bit_cast(s16x4v, __builtin_amdgcn_ds_read_tr16_b64_v4i16((LAS s16x4v*)ap));
                const s16x4v hv = __builtin_bit_cast(s16x4v, __builtin_amdgcn_ds_read_tr16_b64_v4i16((LAS s16x4v*)(ap + 8 * 144)));
                const pg8::bf16x8 vf = (pg8::bf16x8){lo[0], lo[1], lo[2], lo[3], hv[0], hv[1], hv[2], hv[3]};
                if (dh == 0) o0 = __builtin_amdgcn_mfma_f32_32x32x16_bf16(pa, vf, o0, 0, 0, 0); else o1 = __builtin_amdgcn_mfma_f32_32x32x16_bf16(pa, vf, o1, 0, 0, 0);
            }
        }
    }
    const float il = 1.f / l;
    if (hi == 0) LSE[((size_t)g * NT + rowb + tq) * 4 + hh] = m + log2f(l);
    unsigned char* og = (unsigned char*)OG + (size_t)g * NT * 256;
#pragma unroll
    for (int rg = 0; rg < 16; ++rg) { const int q = (rg & 3) + 8 * (rg >> 2) + 4 * hi; const float ilq = __shfl(il, q);
        *(LAS bf16*)(vl + q * 144 + r32 * 2) = f2bf(o0[rg] * ilq); *(LAS bf16*)(vl + q * 144 + 64 + r32 * 2) = f2bf(o1[rg] * ilq); }
#pragma unroll
    for (int i = 0; i < 2; ++i) { const int id = i * 64 + lane, row = id >> 2, c16 = id & 3; const v4u wa = *(const LAS v4u*)(vl + row * 144 + c16 * 32), wb = *(const LAS v4u*)(vl + row * 144 + c16 * 32 + 16);
        v4u o;
#pragma unroll
        for (int k = 0; k < 2; ++k) { o[k] = pk4_fp8(__uint_as_float(wa[2 * k] << 16) * SC_ATT, __uint_as_float(wa[2 * k] & 0xffff0000u) * SC_ATT, __uint_as_float(wa[2 * k + 1] << 16) * SC_ATT, __uint_as_float(wa[2 * k + 1] & 0xffff0000u) * SC_ATT);
            o[2 + k] = pk4_fp8(__uint_as_float(wb[2 * k] << 16) * SC_ATT, __uint_as_float(wb[2 * k] & 0xffff0000u) * SC_ATT, __uint_as_float(wb[2 * k + 1] << 16) * SC_ATT, __uint_as_float(wb[2 * k + 1] & 0xffff0000u) * SC_ATT); }
        *(v4u*)(og + (rowb + (size_t)((32 * ub + row) * dil + r)) * 256 + hh * 64 + 16 * c16) = o; }
}
__device__ __forceinline__ void dil_phase(Frame& F, const bf16* QA, const bf16* KA, const bf16* VA, bf16* OG, float* LSE, bf16* ATT) {
    LAS unsigned char* vl = F.lds + F.wave * 9216;
    for (int unit = F.vcu; unit < NB * 16; unit += F.G) {
        const int b = unit >> 4, hh = (unit >> 2) & 3, tb = unit & 3;
        for (int wt = F.wave; wt < 48; wt += NWAVES) { const int g = wt >> 4, j = wt & 15;
            const int r = (g == 0) ? 0 : (g == 1) ? (j & 3) : j; const int ub = (g == 0) ? 16 * tb + j : (g == 1) ? 4 * tb + (j >> 2) : tb;
            dil_tile(QA, KA, VA, OG, LSE, vl, b, g, hh, r, ub, F.lane); }
        VM_WAIT(); __syncthreads();
        {
            typedef float f2_ __attribute__((ext_vector_type(2)));
            const unsigned char* og8 = (const unsigned char*)OG;
#pragma unroll 2
            for (int it = 0; it < 4; ++it) { const int tk = it * 128 + (F.tid >> 2), c16 = F.tid & 3;
                const size_t row = (size_t)b * SEQ + 512 * tb + tk;
                const float l0 = LSE[(row) * 4 + hh], l1 = LSE[((size_t)NT + row) * 4 + hh], l2 = LSE[((size_t)2 * NT + row) * 4 + hh];
                const float mx = fmaxf(l0, fmaxf(l1, l2)); float w0 = exp2f(l0 - mx), w1 = exp2f(l1 - mx), w2 = exp2f(l2 - mx); const float iw = 1.f / (w0 + w1 + w2); w0 *= iw; w1 *= iw; w2 *= iw;
                const v4u a = *(const v4u*)(og8 + row * 256 + hh * 64 + 16 * c16), bb = *(const v4u*)(og8 + ((size_t)NT + row) * 256 + hh * 64 + 16 * c16), c = *(const v4u*)(og8 + ((size_t)2 * NT + row) * 256 + hh * 64 + 16 * c16);
                v4u o;
#pragma unroll
                for (int k = 0; k < 4; ++k) { const f2_ al = __builtin_amdgcn_cvt_pk_f32_fp8((int)a[k], false), ah = __builtin_amdgcn_cvt_pk_f32_fp8((int)a[k], true), bl = __builtin_amdgcn_cvt_pk_f32_fp8((int)bb[k], false), bh = __builtin_amdgcn_cvt_pk_f32_fp8((int)bb[k], true),
                        cl = __builtin_amdgcn_cvt_pk_f32_fp8((int)c[k], false), ch_ = __builtin_amdgcn_cvt_pk_f32_fp8((int)c[k], true);
                    o[k] = pk4_fp8(w0 * al[0] + w1 * bl[0] + w2 * cl[0], w0 * al[1] + w1 * bl[1] + w2 * cl[1], w0 * ah[0] + w1 * bh[0] + w2 * ch_[0], w0 * ah[1] + w1 * bh[1] + w2 * ch_[1]); }
                *(v4u*)((unsigned char*)ATT + row * 1280 + hh * 64 + 16 * c16) = o; }
        }
    }
    __syncthreads();
}


__device__ __forceinline__ float sigmoid_rcp_(float x) { return __builtin_amdgcn_rcpf(1.f + __expf(-x)); }
__device__ __forceinline__ void topk_panel(Frame& F, const float* LOGITS, const float* rbias, int p, int* IDX, float* GATEV, int* POSE, int* counts) {
    typedef float f4 __attribute__((ext_vector_type(4)));
    LAS f4* sl = (LAS f4*)F.lds;
    LAS f4* sb = (LAS f4*)(F.lds + MOE_LDS_OFF);
    if (F.tid < 64) sb[F.tid] = *(const f4*)(rbias + 4 * F.tid);
    for (int half = 0; half < 2; ++half) {
        __syncthreads();
        const float* src = LOGITS + (size_t)(p * 256 + half * 128) * NEXP;
#pragma unroll 4
        for (int i = 0; i < 16; ++i) { const int id = i * 512 + F.tid, row = id >> 6, c4 = id & 63; sl[row * 64 + (c4 ^ (row & 63))] = *(const f4*)(src + (size_t)row * NEXP + 4 * c4); }
        __syncthreads();
        if (F.tid < 128) {
            const int row = F.tid, sw = row & 63; const LAS f4* rp = sl + row * 64;
            float gs[8];
#pragma unroll
            for (int g = 0; g < 8; ++g) { float m1 = -INFINITY, m2 = -INFINITY;
#pragma unroll
                for (int c = 0; c < 8; ++c) { const f4 lg = rp[(8 * g + c) ^ sw], bb = sb[8 * g + c];
#pragma unroll
                    for (int j = 0; j < 4; ++j) { const float v = sigmoid_rcp_(lg[j]) + bb[j]; const float lo = fminf(m1, v); m1 = fmaxf(m1, v); m2 = fmaxf(m2, lo); } }
                gs[g] = m1 + m2; }
            unsigned mask = 0u;
#pragma unroll
            for (int g = 0; g < 8; ++g) { int rank = 0;
#pragma unroll
                for (int g2 = 0; g2 < 8; ++g2) rank += (gs[g2] > gs[g] || (gs[g2] == gs[g] && g2 < g)) ? 1 : 0;
                mask |= (rank < 4) ? (1u << g) : 0u; }
            float tv[8]; int ti[8];
#pragma unroll
            for (int k = 0; k < 8; ++k) { tv[k] = -INFINITY; ti[k] = 0; }
#pragma unroll 1
            for (int jg = 0; jg < 4; ++jg) { const int g = __ffs(mask) - 1; mask &= mask - 1u;
#pragma unroll 2
                for (int c = 0; c < 8; ++c) { const f4 lg = rp[(8 * g + c) ^ sw], bb = sb[8 * g + c];
#pragma unroll
                    for (int j = 0; j < 4; ++j) { float cv = sigmoid_rcp_(lg[j]) + bb[j]; int ci = 32 * g + 4 * c + j;
#pragma unroll
                        for (int k = 0; k < 8; ++k) { const bool gt = cv > tv[k]; const float ov = tv[k]; const int oi = ti[k]; tv[k] = gt ? cv : ov; ti[k] = gt ? ci : oi; cv = gt ? ov : cv; ci = gt ? oi : ci; } } } }
            float sc[8]; float ssum = 0.f;
#pragma unroll
            for (int k = 0; k < 8; ++k) { const int e = ti[k]; const float lgv = ((const LAS float*)(rp + ((e >> 2) ^ sw)))[e & 3]; sc[k] = sigmoid_rcp_(lgv); ssum += sc[k]; }
            const int t = p * 256 + half * 128 + row; const int chunk = t / CH_TOK; const float inv = 2.5f / ssum;
            int ps[8];
#pragma unroll
            for (int k = 0; k < 8; ++k) ps[k] = atomicAdd(&counts[chunk * NEXP + ti[k]], 1);
            *(int4*)(IDX + (size_t)t * TOPK) = make_int4(ti[0], ti[1], ti[2], ti[3]); *(int4*)(IDX + (size_t)t * TOPK + 4) = make_int4(ti[4], ti[5], ti[6], ti[7]);
            *(float4*)(GATEV + (size_t)t * TOPK) = make_float4(sc[0] * inv, sc[1] * inv, sc[2] * inv, sc[3] * inv); *(float4*)(GATEV + (size_t)t * TOPK + 4) = make_float4(sc[4] * inv, sc[5] * inv, sc[6] * inv, sc[7] * inv);
            *(int4*)(POSE + (size_t)t * TOPK) = make_int4(ps[0], ps[1], ps[2], ps[3]); *(int4*)(POSE + (size_t)t * TOPK + 4) = make_int4(ps[4], ps[5], ps[6], ps[7]);
        }
    }
    __syncthreads();
}

__device__ __forceinline__ void ph_mod(Frame& F, const float* c, const float* w_ada, const float* b_ada, float* MOD) {
    LAS float* sc = (LAS float*)(F.lds + F.wave * 16384);
    for (int unit = F.vcu; unit < 96; unit += F.G) {
        const int k0 = F.wave * 128;
        for (int e = F.lane; e < 32 * 128; e += 64) { const int b = e >> 7, kk = e & 127; const float cv = c[b * DM + k0 + kk]; sc[e] = cv / (1.f + __expf(-cv)); }
        LDS_WAIT();
        float acc[32];
#pragma unroll
        for (int b = 0; b < 32; ++b) acc[b] = 0.f;
        const float* wp = w_ada + (size_t)k0 * 6144 + unit * 64 + F.lane;
        for (int kk = 0; kk < 128; ++kk) { const float w = wp[(size_t)kk * 6144];
#pragma unroll
            for (int b = 0; b < 32; ++b) acc[b] += sc[b * 128 + kk] * w; }
        __syncthreads();
        LAS float* part = (LAS float*)F.lds;
#pragma unroll
        for (int b = 0; b < 32; ++b) part[(F.wave * 32 + b) * 64 + F.lane] = acc[b];
        __syncthreads();
        for (int e = F.tid; e < 2048; e += 512) { float s = 0.f;
#pragma unroll
            for (int w = 0; w < 8; ++w) s += part[w * 2048 + e];
            const int b = e >> 6, j = unit * 64 + (e & 63); MOD[b * 6144 + j] = s + b_ada[j]; }
        __syncthreads();
    }
}
__device__ __forceinline__ void ph_tables(Frame& F, float* rope) {
    float* C1 = rope; float* S1 = rope + 65536; float* CR = rope + 131072; float* SR = CR + 512; float* CC = SR + 512; float* SC = CC + 1024;
    const int gt = F.vcu * 512 + F.tid, NG = F.G * 512;
    for (int idx = gt; idx < 65536; idx += NG) { const int t = idx >> 5, j = idx & 31; const double a = (double)t * pow(10000.0, -(double)j / 32.0); C1[idx] = (float)cos(a); S1[idx] = (float)sin(a); }
    for (int idx = gt; idx < 1024; idx += NG) { const int p = idx >> 4, j = idx & 15; const double a = (double)p * pow(10000.0, -(double)j / 16.0); const float cv = (float)cos(a), sv = (float)sin(a);
        CC[idx] = cv; SC[idx] = sv; if (idx < 512) { CR[idx] = cv; SR[idx] = sv; } }
}
__device__ __forceinline__ void norm_row_from_bf16(const bf16* xrow, const float* g, const float* shift, const float* scale, bf16* orow, unsigned char* o8, int lane) {
    f32x4 v[4]; float ss = 0.f;
#pragma unroll
    for (int h = 0; h < 2; ++h) { const v4u w = *(const v4u*)(xrow + 8 * lane + 512 * h);
        v[2 * h] = (f32x4){__uint_as_float(w.x << 16), __uint_as_float(w.x & 0xffff0000u), __uint_as_float(w.y << 16), __uint_as_float(w.y & 0xffff0000u)};
        v[2 * h + 1] = (f32x4){__uint_as_float(w.z << 16), __uint_as_float(w.z & 0xffff0000u), __uint_as_float(w.w << 16), __uint_as_float(w.w & 0xffff0000u)}; }
#pragma unroll
    for (int j = 0; j < 4; ++j) ss += (v[j].x * v[j].x + v[j].y * v[j].y) + (v[j].z * v[j].z + v[j].w * v[j].w);
    const float rstd = 1.f / sqrtf(wave_sum(ss) * (1.f / DM) + NORM_EPS);
#pragma unroll
    for (int h = 0; h < 2; ++h) { f32x4 y[2];
#pragma unroll
        for (int q = 0; q < 2; ++q) { const int cidx = 8 * lane + 512 * h + 4 * q; const f32x4 gg = *(const f32x4*)(g + cidx), sh = *(const f32x4*)(shift + cidx), sc = *(const f32x4*)(scale + cidx); y[q] = v[2 * h + q] * rstd * gg * (sc + 1.f) + sh; }
        v4u w; w.x = pk2(y[0].x, y[0].y); w.y = pk2(y[0].z, y[0].w); w.z = pk2(y[1].x, y[1].y); w.w = pk2(y[1].z, y[1].w);
        *(v4u*)(orow + 8 * lane + 512 * h) = w;
        if (o8) { v2u w8; w8.x = pk4_fp8(y[0].x * SC_H2, y[0].y * SC_H2, y[0].z * SC_H2, y[0].w * SC_H2); w8.y = pk4_fp8(y[1].x * SC_H2, y[1].y * SC_H2, y[1].z * SC_H2, y[1].w * SC_H2); *(v2u*)(o8 + 8 * lane + 512 * h) = w8; } }
}
__device__ __forceinline__ void norm_row_bf16(const float* xrow, const float* g, const float* shift, const float* scale, bf16* orow, int lane) {
    const GAS f32x4* xr = (const GAS f32x4*)xrow + lane;
    f32x4 v[4]; float ss = 0.f;
#pragma unroll
    for (int j = 0; j < 4; ++j) { v[j] = xr[64 * j]; ss += (v[j].x * v[j].x + v[j].y * v[j].y) + (v[j].z * v[j].z + v[j].w * v[j].w); }
    const float rstd = 1.f / sqrtf(wave_sum(ss) * (1.f / DM) + NORM_EPS);
    GAS v2u* o8 = (GAS v2u*)orow + lane;
#pragma unroll
    for (int j = 0; j < 4; ++j) { const int cidx = 4 * lane + 256 * j; const f32x4 gg = *(const f32x4*)(g + cidx), sh = *(const f32x4*)(shift + cidx), sc = *(const f32x4*)(scale + cidx);
        const f32x4 y = v[j] * rstd * gg * (sc + 1.f) + sh; v2u w; w.x = pk2(y.x, y.y); w.y = pk2(y.z, y.w); o8[64 * j] = w; }
}

__device__ __forceinline__ void norm_row_fp8(const float* xrow, const float* g, const float* shift, const float* scale, unsigned char* orow, int lane) {
    const GAS f32x4* xr = (const GAS f32x4*)xrow + lane;
    f32x4 v[4]; float ss = 0.f;
#pragma unroll
    for (int j = 0; j < 4; ++j) { v[j] = xr[64 * j]; ss += (v[j].x * v[j].x + v[j].y * v[j].y) + (v[j].z * v[j].z + v[j].w * v[j].w); }
    const float rstd = 1.f / sqrtf(wave_sum(ss) * (1.f / DM) + NORM_EPS);
    GAS unsigned* o4 = (GAS unsigned*)orow + lane;
#pragma unroll
    for (int j = 0; j < 4; ++j) { const int cidx = 4 * lane + 256 * j; const f32x4 gg = *(const f32x4*)(g + cidx), sh = *(const f32x4*)(shift + cidx), sc = *(const f32x4*)(scale + cidx);
        const f32x4 y = (v[j] * rstd * gg * (sc + 1.f) + sh) * SC_H1; o4[64 * j] = pk4_fp8(y.x, y.y, y.z, y.w); }
}

__global__ void __launch_bounds__(NWAVES * 64, 2) mk_fwd(Args args) {
    extern __shared__ __attribute__((aligned(16))) unsigned char lds[];
    Frame F;
    F.lds = (LAS unsigned char*)lds; F.MISC = (volatile LAS unsigned*)(F.lds + MISC_OFF); F.ws = args.ws;
    F.tid = threadIdx.x; F.lane = F.tid & 63; F.wave = __builtin_amdgcn_readfirstlane(F.tid >> 6); asm volatile("" : "+s"(F.wave));
    F.G = gridDim.x; { const int bx = blockIdx.x; F.vcu = (F.G % 8 == 0) ? (bx % 8) * (F.G / 8) + bx / 8 : bx; }
    unsigned char* ws = args.ws;
    for (int u = F.tid; u < (LDS_BYTES - LDSCTL_OFF) / 4; u += NWAVES * 64) ((LAS unsigned*)(F.lds + LDSCTL_OFF))[u] = 0u;
    __syncthreads();
    XcdBarrier bar = xcd_barrier_post((unsigned*)(ws + WS_CTL + WS_BAR) + args.li * XCD_BAR_WORDS, F.MISC + 8, F.wave);
    const int lo = args.ph_lo, hi = args.ph_hi;
#define IN(k) (lo <= (k) && (k) < hi)
#define PHASE_PIN() do { const int t_ = hw_tid(F.wave); F.tid = t_; F.lane = t_ & 63; } while (0)
#define BOTH(k) (IN(k) && IN((k) + 1))
    const float* x = args.in[0];
    float* MOD = (float*)(ws + WS_MOD); float* ROPE = (float*)(ws + WS_ROPE);
    unsigned char* H8 = (unsigned char*)args.out;
    bf16* DHI = (bf16*)args.out + (size_t)NT * DM;
    bf16* XMB = (bf16*)(ws + WS_A);
    const int gw = F.vcu * NWAVES + F.wave, NGW = F.G * NWAVES;

    if (IN(PH_PRO)) { PHASE_PIN();
        ph_mod(F, args.in[1], args.in[2], args.in[3], MOD);
        ph_tables(F, ROPE);
        LAS float* scr = (LAS float*)(F.lds + F.wave * 16384);
        constexpr int I_WIN = (DM / 64) * (INW / 32);
        for (int it = gw; it < I_WIN; it += NGW) p0_transpose_item8(args.in[5], DM, INW, ws + WS_WIN_T, DM, RmWin{}, scr, it, F.lane, SC_WIN);
        { constexpr int I_D = (256 / 64) * (DM / 32), I_G = (DM / 64) * (DM / 32);
          unsigned char* WC = ws + WS_WCAT_T; unsigned char* WO = ws + WS_WOUT_T;
          for (int it = gw; it < I_D + 2 * I_G; it += NGW) {
              if (it < I_D) p0_transpose_item8(args.in[9], 256, DM, WC, 1280, RmId{0}, scr, it, F.lane, SC_WMIX);
              else if (it < I_D + I_G) p0_transpose_item8(args.in[10], DM, DM, WC + 256, 1280, RmId{0}, scr, it - I_D, F.lane, SC_WMIX);
              else p0_transpose_item8(args.in[11], DM, DM, WO, DM, RmId{0}, scr, it - I_D - I_G, F.lane, SC_WMIX); } }
        { constexpr int I_R = (DM / 64) * (256 / 32), I_SD = (256 / 64) * (DM / 32);
          bf16* WR = (bf16*)(ws + WS_WRS_T); bf16* WD = (bf16*)(ws + WS_WSD_T);
          for (int it = gw; it < 3 * I_R + I_SD; it += NGW) {
              if (it < I_R) p0_transpose_item(args.in[13], DM, 256, WR, DM, RmId{0}, scr, it, F.lane);
              else if (it < 2 * I_R) p0_transpose_item(args.in[18], DM, 256, WR, DM, RmSh{256}, scr, it - I_R, F.lane);
              else if (it < 3 * I_R) p0_transpose_item(args.in[19], DM, 256, WR, DM, RmSh{384}, scr, it - 2 * I_R, F.lane);
              else p0_transpose_item(args.in[20], 256, DM, WD, 256, RmId{0}, scr, it - 3 * I_R, F.lane); } }
        if (BOTH(PH_PRO)) xcd_barrier(bar);
    }
    if (IN(PH_NORM1)) { PHASE_PIN();
        if (NT % NGW == 0 && SEQ % (NT / NGW) == 0) {
            constexpr float S1 = SC_H1; const int RPW = NT / NGW, m0 = gw * RPW, b = m0 / SEQ, lane = F.lane;
            const float* gp = args.in[4]; const float* shp = MOD + b * 6144; const float* scp = shp + DM;
            f32x4 ga[4], sh[4];
#pragma unroll
            for (int j = 0; j < 4; ++j) { const int cidx = 4 * lane + 256 * j; ga[j] = *(const f32x4*)(gp + cidx) * (*(const f32x4*)(scp + cidx) + 1.f) * S1; sh[j] = *(const f32x4*)(shp + cidx) * S1; }
            const GAS f32x4* xr = (const GAS f32x4*)(x + (size_t)m0 * DM) + lane; GAS unsigned* o4 = (GAS unsigned*)(H8 + (size_t)m0 * DM) + lane;
            f32x4 cur[4], nxt[4];
#pragma unroll
            for (int j = 0; j < 4; ++j) cur[j] = xr[64 * j];
            for (int i = 0; i < RPW; ++i) {
                if (i + 1 < RPW) {
#pragma unroll
                    for (int j = 0; j < 4; ++j) nxt[j] = xr[(size_t)(i + 1) * 256 + 64 * j]; }
                float ss = 0.f;
#pragma unroll
                for (int j = 0; j < 4; ++j) ss += (cur[j].x * cur[j].x + cur[j].y * cur[j].y) + (cur[j].z * cur[j].z + cur[j].w * cur[j].w);
                const float rstd = 1.f / sqrtf(wave_sum(ss) * (1.f / DM) + NORM_EPS);
#pragma unroll
                for (int j = 0; j < 4; ++j) { const f32x4 y = cur[j] * rstd * ga[j] + sh[j]; o4[(size_t)i * 256 + 64 * j] = pk4_fp8(y.x, y.y, y.z, y.w); }
#pragma unroll
                for (int j = 0; j < 4; ++j) cur[j] = nxt[j];
            }
        } else
        for (int m = gw; m < NT; m += NGW) { const int b = m / SEQ; norm_row_fp8(x + (size_t)m * DM, args.in[4], MOD + b * 6144, MOD + b * 6144 + DM, H8 + (size_t)m * DM, F.lane); }
        if (BOTH(PH_NORM1)) xcd_barrier(bar);
    }
    if (IN(PH_PROJ)) { PHASE_PIN();
        pg8::Gemm g{(const bf16*)H8, (const bf16*)(ws + WS_WIN_T), NT, INW, DM, DM, DM}; pg8::StaticOrder S; S.init(NT, INW, F.G, (int)blockIdx.x);
        EpiP1 E{ws, ROPE, args.in[7], args.in[8], args.in[6]};
        pg8::gemm_phase<EpiP1, pg8::StaticOrder>(F.lds, g, S, E, F.wave);
        if (BOTH(PH_PROJ)) xcd_barrier(bar);
    }
    if (IN(PH_ATT)) { PHASE_PIN();
        dil_phase(F, (const bf16*)(ws + WS_QA), (const bf16*)(ws + WS_KA), (const bf16*)(ws + WS_VA), (bf16*)(ws + WS_OG), (float*)(ws + WS_LSE), (bf16*)(ws + WS_ATT));
        __syncthreads();
        const attn_body::AttnTensors AT{(const attn_body::bf16*)(ws + WS_QB), (const attn_body::bf16*)(ws + WS_KB), (const attn_body::bf16*)(ws + WS_VB), (attn_body::bf16*)(ws + WS_ATT)};
        const attn_body::StaticOrder S(F.vcu, F.G);
        attn_body::attn_phase<attn_body::StaticOrder>((char*)lds, AT, S, F.wave);
        if (BOTH(PH_ATT)) xcd_barrier(bar);
    }
    if (IN(PH_MIX1)) { PHASE_PIN();
        pg8::Gemm g{(const bf16*)(ws + WS_ATT), (const bf16*)(ws + WS_WCAT_T), NT, DM, 1280, 1280, 1280}; pg8::StaticOrder S; S.init(NT, DM, F.G, (int)blockIdx.x);
        EpiGatedF E{(const bf16*)(ws + WS_GATES), (unsigned char*)DHI};
        pg8::gemm_phase<EpiGatedF, pg8::StaticOrder>(F.lds, g, S, E, F.wave);
        if (BOTH(PH_MIX1)) xcd_barrier(bar);
    }
    if (IN(PH_MIX2)) { PHASE_PIN();
        pg8::Gemm g{DHI, (const bf16*)(ws + WS_WOUT_T), NT, DM, DM, DM, DM}; pg8::StaticOrder S; S.init(NT, DM, F.G, (int)blockIdx.x);
        EpiXmidF E{x, MOD, XMB};
        pg8::gemm_phase<EpiXmidF, pg8::StaticOrder>(F.lds, g, S, E, F.wave);
        if (BOTH(PH_MIX2)) xcd_barrier(bar);
    }
    if (IN(PH_NORM2)) { PHASE_PIN();
        bf16* H2 = DHI; unsigned char* H2F = (unsigned char*)args.out;
        if (NT % NGW == 0 && SEQ % (NT / NGW) == 0) {
            const int RPW = NT / NGW, m0 = gw * RPW, b = m0 / SEQ, lane = F.lane;
            const float* gp = args.in[12]; const float* shp = MOD + b * 6144 + 3 * DM; const float* scp = MOD + b * 6144 + 4 * DM;
            f32x4 ga[4], sh[4];
#pragma unroll
            for (int j = 0; j < 4; ++j) { const int cidx = 8 * lane + 512 * (j >> 1) + 4 * (j & 1); ga[j] = *(const f32x4*)(gp + cidx) * (*(const f32x4*)(scp + cidx) + 1.f); sh[j] = *(const f32x4*)(shp + cidx); }
            const bf16* xr = XMB + (size_t)m0 * DM + 8 * lane; bf16* orow = H2 + (size_t)m0 * DM + 8 * lane; unsigned char* o8 = H2F + (size_t)m0 * DM + 8 * lane;
            v4u cur[2], nxt[2], nx2[2], nx3[2];
            cur[0] = *(const v4u*)xr; cur[1] = *(const v4u*)(xr + 512);
            if (RPW > 1) { nxt[0] = *(const v4u*)(xr + DM); nxt[1] = *(const v4u*)(xr + DM + 512); }
            if (RPW > 2) { nx2[0] = *(const v4u*)(xr + 2 * DM); nx2[1] = *(const v4u*)(xr + 2 * DM + 512); }
            for (int i = 0; i < RPW; ++i) {
                if (i + 3 < RPW) { nx3[0] = *(const v4u*)(xr + (size_t)(i + 3) * DM); nx3[1] = *(const v4u*)(xr + (size_t)(i + 3) * DM + 512); }
                f32x4 v[4]; float ss = 0.f;
#pragma unroll
                for (int h = 0; h < 2; ++h) { const v4u w = cur[h];
                    v[2 * h] = (f32x4){__uint_as_float(w.x << 16), __uint_as_float(w.x & 0xffff0000u), __uint_as_float(w.y << 16), __uint_as_float(w.y & 0xffff0000u)};
                    v[2 * h + 1] = (f32x4){__uint_as_float(w.z << 16), __uint_as_float(w.z & 0xffff0000u), __uint_as_float(w.w << 16), __uint_as_float(w.w & 0xffff0000u)}; }
#pragma unroll
                for (int j = 0; j < 4; ++j) ss += (v[j].x * v[j].x + v[j].y * v[j].y) + (v[j].z * v[j].z + v[j].w * v[j].w);
                const float rstd = 1.f / sqrtf(wave_sum(ss) * (1.f / DM) + NORM_EPS);
#pragma unroll
                for (int h = 0; h < 2; ++h) { const f32x4 y0 = v[2 * h] * rstd * ga[2 * h] + sh[2 * h], y1 = v[2 * h + 1] * rstd * ga[2 * h + 1] + sh[2 * h + 1];
                    v4u w; w.x = pk2(y0.x, y0.y); w.y = pk2(y0.z, y0.w); w.z = pk2(y1.x, y1.y); w.w = pk2(y1.z, y1.w);
                    *(v4u*)(orow + (size_t)i * DM + 512 * h) = w;
                    v2u w8; w8.x = pk4_fp8(y0.x * SC_H2, y0.y * SC_H2, y0.z * SC_H2, y0.w * SC_H2); w8.y = pk4_fp8(y1.x * SC_H2, y1.y * SC_H2, y1.z * SC_H2, y1.w * SC_H2); *(v2u*)(o8 + (size_t)i * DM + 512 * h) = w8; }
                cur[0] = nxt[0]; cur[1] = nxt[1]; nxt[0] = nx2[0]; nxt[1] = nx2[1]; nx2[0] = nx3[0]; nx2[1] = nx3[1];
            }
        } else
        for (int m = gw; m < NT; m += NGW) { const int b = m / SEQ; norm_row_from_bf16(XMB + (size_t)m * DM, args.in[12], MOD + b * 6144 + 3 * DM, MOD + b * 6144 + 4 * DM, H2 + (size_t)m * DM, H2F + (size_t)m * DM, F.lane); }
        { LAS float* scr = (LAS float*)(F.lds + F.wave * 16384);
          unsigned char* WGU = (unsigned char*)(ws + WS_WGU); unsigned char* WDN = (unsigned char*)(ws + WS_WD);
          for (int it = gw; it < NEXP * 384; it += NGW) { const int e = it / 384, r = it - e * 384;
              if (r < 128) p0_transpose_item8(args.in[15] + (size_t)e * DM * EFF, DM, EFF, WGU + (size_t)e * 512 * DM, DM, RmSh{0}, scr, r, F.lane, SC_WGU);
              else if (r < 256) p0_transpose_item8(args.in[16] + (size_t)e * DM * EFF, DM, EFF, WGU + (size_t)e * 512 * DM, DM, RmSh{128}, scr, r - 128, F.lane, SC_WGU);
              else p0_transpose_item8(args.in[17] + (size_t)e * EFF * DM, EFF, DM, WDN + (size_t)e * DM * EFF, EFF, RmId{0}, scr, r - 256, F.lane, SC_WD); } }
        if (BOTH(PH_NORM2)) xcd_barrier(bar);
    }
    if (IN(PH_RS)) { PHASE_PIN();
        const bf16* H2 = DHI; float* LOGITS = (float*)(ws + WS_LOGITS); bf16* SHACT = (bf16*)(ws + WS_SHACT);
        PanelOrder S; S.init(NT, 768, F.G, F.vcu);
        { pg8::Gemm g{H2, (const bf16*)(ws + WS_WRS_T), NT, 768, DM, DM, DM}; EpiRS E{LOGITS, SHACT};
          pg8::gemm_phase<EpiRS, PanelOrder>(F.lds, g, S, E, F.wave); }
        PHASE_PIN(); VM_WAIT(); __syncthreads();
        if (F.wave == 0) { __builtin_amdgcn_fence(__ATOMIC_ACQUIRE, "agent"); VM_WAIT(); }
        __syncthreads();
        for (int p = F.vcu; p < NT / 256; p += F.G) topk_panel(F, LOGITS, args.in[14], p, (int*)(ws + WS_IDX), (float*)(ws + WS_GATEV), (int*)(ws + WS_POSE), (int*)(ws + WS_CTL) + CW_COUNTS);
        if (BOTH(PH_RS)) xcd_barrier(bar);
    }
    if (IN(PH_SCAT)) { PHASE_PIN();
        { pg8::StaticOrder S2; S2.init(NT, DM, F.G, (int)blockIdx.x);
          pg8::Gemm g{(const bf16*)(ws + WS_SHACT), (const bf16*)(ws + WS_WSD_T), NT, DM, 256, 256, 256}; EpiShDownF E{MOD, XMB};
          pg8::gemm_phase<EpiShDownF, pg8::StaticOrder>(F.lds, g, S2, E, F.wave); }
        __syncthreads(); PHASE_PIN();
        LAS int* sc = (LAS int*)F.lds; const int* counts = (const int*)(ws + WS_CTL) + CW_COUNTS; int* misc = (int*)(ws + WS_MISC);
        const int cn = counts[F.tid]; sc[F.tid] = (cn + 255) & ~255;
        __syncthreads();
        for (int o = 1; o < 256; o <<= 1) { const int e = F.tid & 255; const int v = (e >= o) ? sc[F.tid - o] : 0; __syncthreads(); sc[F.tid] += v; __syncthreads(); }
        const int pend = sc[F.tid], pstart = pend - ((cn + 255) & ~255);
        sc[512 + F.tid] = pstart;
        if (blockIdx.x == 0) { misc[MW_PSTART + F.tid] = pstart; misc[MW_PEND + F.tid] = pend; misc[MW_CNT + F.tid] = cn; }
        sc[1024 + F.tid] = pend;
        __syncthreads();
        if (blockIdx.x == 0) { int* blke = (int*)(ws + WS_BLKE);
            for (int i = F.tid; i < NCHUNK * BLK_PER_CH; i += 512) { const int c = i / BLK_PER_CH, g = i - c * BLK_PER_CH; const int pos = 256 * g; int lo = 0, hi = NEXP;
                while (lo < hi) { const int mid = (lo + hi) >> 1; if (sc[1024 + c * NEXP + mid] > pos) hi = mid; else lo = mid + 1; }
                blke[i] = (lo < NEXP) ? lo : -1; } }
        const int* IDX = (const int*)(ws + WS_IDX); const float* GATEV = (const float*)(ws + WS_GATEV); const int* POSE = (const int*)(ws + WS_POSE);
        int* STOK = (int*)(ws + WS_STOK); float* SGATE = (float*)(ws + WS_SGATE);
        for (int i = F.vcu * 512 + F.tid; i < NT * TOPK; i += F.G * 512) { const int t = i >> 3; const int c = t / CH_TOK; const int e = IDX[i];
            const int slot = c * CH_SLOTS + sc[512 + c * NEXP + e] + POSE[i]; STOK[slot] = i; SGATE[slot] = GATEV[i]; }
        __syncthreads();
        if (BOTH(PH_SCAT)) xcd_barrier(bar);
    }
#define EXPERT_PHASE(PH, CH) if (IN(PH)) { PHASE_PIN(); \
        LAS int* mblk = (LAS int*)(F.lds + MOE_LDS_OFF); LAS int* tcode = mblk + 64; LAS float* tgate = (LAS float*)(tcode + 512); \
        if (F.tid < MOE_MAXMU) { const int g_ = F.vcu + F.tid * F.G; mblk[F.tid] = (g_ < BLK_PER_CH) ? ld_agent((const int*)(ws + WS_BLKE) + CH * BLK_PER_CH + g_) : -1; } \
        __syncthreads(); \
        MoeOrder S{CH, F.G, F.vcu, mblk, (const char*)args.out, (const char*)(ws + WS_WGU), (const char*)(ws + WS_WD), (const char*)(ws + WS_ACTS) + (size_t)blockIdx.x * 131072}; \
        EpiT1 E1{tgate, (char*)(ws + WS_ACTS) + (size_t)blockIdx.x * 131072}; EpiT2 E2{tcode, (char*)(ws + WS_YT), CH * CH_TOK * TOPK}; \
        gemm_phase_moe<EpiT1, EpiT2>(F.lds, S, E1, E2, (const int*)(ws + WS_STOK), (const float*)(ws + WS_SGATE), tcode, tgate, F.wave); \
        if (BOTH(PH)) xcd_barrier(bar); }
#define COMBINE_PHASE(PH, CH) if (IN(PH)) { PHASE_PIN(); \
        if (CH_TOK % NGW == 0 && SEQ % (CH_TOK / NGW) == 0) {     \
            const int RPW = CH_TOK / NGW, tl0 = gw * RPW, b = (CH * CH_TOK + tl0) / SEQ; f32x4 g2v[4], fgv[4]; \
            _Pragma("unroll") for (int q = 0; q < 4; ++q) { g2v[q] = *(const f32x4*)(MOD + b * 6144 + 5 * DM + 16 * F.lane + 4 * q) * (1.f / YT_SCALE); fgv[q] = *(const f32x4*)(args.in[21] + 16 * F.lane + 4 * q); } \
            for (int i = 0; i < RPW; ++i) { const int tl = tl0 + i, t = CH * CH_TOK + tl; \
                combine_row_r(XMB + (size_t)t * DM, args.out + (size_t)t * DM, (const char*)(ws + WS_YT) + (size_t)tl * TOPK * 1024, g2v, fgv, F.lane); } \
        } else \
        for (int tl = gw; tl < CH_TOK; tl += NGW) { const int t = CH * CH_TOK + tl; const int b = t / SEQ; \
            combine_row(XMB + (size_t)t * DM, args.out + (size_t)t * DM, (const char*)(ws + WS_YT) + (size_t)tl * TOPK * 1024, MOD + b * 6144 + 5 * DM, args.in[21], F.lane); } \
        if (BOTH(PH)) xcd_barrier(bar); }
    EXPERT_PHASE(PH_EXP0, 0)
    COMBINE_PHASE(PH_COMB0, 0)
#undef IN
#undef BOTH
}

static int mk_grid = 0;
static void mk_launch(void* const* d_in, void* d_out, void* d_ws, int ph_lo, int ph_hi, int li, hipStream_t stream) {
    if (mk_grid == 0) {
        int dev = 0, cus = 0, per_cu = 0;
        if (hipGetDevice(&dev) != hipSuccess || hipDeviceGetAttribute(&cus, hipDeviceAttributeMultiprocessorCount, dev) != hipSuccess) { mk_grid = -1; return; }
        if (hipFuncSetAttribute((const void*)mk_fwd, hipFuncAttributeMaxDynamicSharedMemorySize, LDS_BYTES) != hipSuccess) { mk_grid = -1; return; }
        if (hipOccupancyMaxActiveBlocksPerMultiprocessor(&per_cu, (const void*)mk_fwd, NWAVES * 64, LDS_BYTES) != hipSuccess || per_cu < 1) { fprintf(stderr, "mk_fwd: occupancy query says %d\n", per_cu); }
        (void)hipGetLastError();
        mk_grid = cus;
    }
    if (mk_grid < 0) return;
    Args a{};
    for (int i = 0; i < 22; ++i) a.in[i] = (const float*)d_in[i];
    a.out = (float*)d_out; a.ws = (unsigned char*)d_ws; a.ph_lo = ph_lo; a.ph_hi = ph_hi; a.li = li; a.pad = 0;
    hipLaunchKernelGGL(mk_fwd, dim3(mk_grid), dim3(NWAVES * 64), LDS_BYTES, stream, a);
}
extern "C" void kernel_launch(void* const* d_in, const int* in_sizes, int n_in, void* d_out, int out_size, void* d_ws, size_t ws_size, hipStream_t stream) {
    if (n_in != 22 || out_size != NT * DM || ws_size < WS_NEED) { fprintf(stderr, "kernel_launch: unexpected shapes (n_in %d out %d ws %zu)\n", n_in, out_size, ws_size); return; }
    const float* x = (const float*)d_in[0]; const float* c = (const float*)d_in[1]; const float* w_ada = (const float*)d_in[2]; const float* b_ada = (const float*)d_in[3];
    const float* norm1_g = (const float*)d_in[4]; const float* w_in = (const float*)d_in[5]; const float* b_gate = (const float*)d_in[6]; const float* qn_g = (const float*)d_in[7];
    const float* kn_g = (const float*)d_in[8]; const float* w_o_dil = (const float*)d_in[9]; const float* w_o_gqa = (const float*)d_in[10]; const float* w_out = (const float*)d_in[11];
    const float* norm2_g = (const float*)d_in[12]; const float* router_w = (const float*)d_in[13]; const float* router_bias = (const float*)d_in[14];
    const float* w_exp_gate = (const float*)d_in[15]; const float* w_exp_up = (const float*)d_in[16]; const float* w_exp_down = (const float*)d_in[17];
    const float* w_sh_gate = (const float*)d_in[18]; const float* w_sh_up = (const float*)d_in[19]; const float* w_sh_down = (const float*)d_in[20]; const float* final_g = (const float*)d_in[21];
    unsigned char* ws = (unsigned char*)d_ws; float* out = (float*)d_out;
    float* MOD = (float*)(ws + WS_MOD); float* ROPE = (float*)(ws + WS_ROPE); int* MISC = (int*)(ws + WS_MISC); int* CTL = (int*)(ws + WS_CTL);
    int* IDX = (int*)(ws + WS_IDX); float* GATEV = (float*)(ws + WS_GATEV); int* POSE = (int*)(ws + WS_POSE); int* STOK = (int*)(ws + WS_STOK); float* SGATE = (float*)(ws + WS_SGATE);
    bf16* H = (bf16*)d_out;
    bf16* QA = (bf16*)(ws + WS_QA); bf16* KA = (bf16*)(ws + WS_KA); bf16* VA = (bf16*)(ws + WS_VA); bf16* QB = (bf16*)(ws + WS_QB); bf16* KB = (bf16*)(ws + WS_KB); bf16* VB = (bf16*)(ws + WS_VB);
    bf16* GATES = (bf16*)(ws + WS_GATES); bf16* ATT = (bf16*)(ws + WS_ATT); bf16* GATED = (bf16*)(ws + WS_GATED); bf16* H2 = (bf16*)(ws + WS_H2);
    float* LOGITS = (float*)(ws + WS_LOGITS); bf16* SHACT = (bf16*)(ws + WS_SHACT); bf16* ACT = (bf16*)(ws + WS_ACT);
    float* YA = out;

    (void)hipMemsetAsync(ws + WS_CTL, 0, 1 * MiB, stream);
    (void)hipMemsetAsync(ws + WS_STOK, 0xFF, (size_t)NCHUNK * CH_SLOTS * 4, stream);
    mk_launch(d_in, d_out, d_ws, PH_PRO, PH_END, 0, stream);
}
```

```cpp
#include <hip/hip_runtime.h>
#include <cstdio>
#include <cstdint>
#include <cmath>

constexpr int NB = 32, SEQ = 2048, DM = 1024, NT = NB * SEQ;
constexpr int HD = 64;
constexpr int DILW = 768, GQW = 1024, GKW = 256, INW = 5888;
constexpr int C_QA = 0, C_KA = 768, C_VA = 1536, C_QB = 2304, C_KB = 3328, C_VB = 3584, C_GT = 3840;
constexpr int NEXP = 256, TOPK = 8, EFF = 256;
constexpr float NORM_EPS = 1e-6f;
constexpr float QSCALE = 0.125f * 1.4426950408889634f;
constexpr int NCHUNK = 1, CH_TOK = NT / NCHUNK;
constexpr int CH_SLOTS = CH_TOK * TOPK + NEXP * 256;

constexpr size_t MiB = 1u << 20;
constexpr size_t WS_CTL = 0;
constexpr size_t WS_MOD = 1 * MiB;
constexpr size_t WS_ROPE = 2 * MiB;
constexpr size_t WS_MISC = 3 * MiB;
constexpr size_t WS_RT = 4 * MiB;
constexpr size_t WS_IDX = WS_RT;
constexpr size_t WS_GATEV = WS_RT + 2 * MiB;
constexpr size_t WS_POSE = WS_RT + 4 * MiB;
constexpr size_t WS_STOK = WS_RT + 6 * MiB;
constexpr size_t WS_SGATE = WS_RT + 9 * MiB;
constexpr size_t WS_A = 16 * MiB;
constexpr size_t WS_QA = WS_A, WS_KA = WS_QA + 96 * MiB, WS_VA = WS_KA + 96 * MiB, WS_QB = WS_VA + 96 * MiB, WS_KB = WS_QB + 128 * MiB, WS_VB = WS_KB + 32 * MiB,
                 WS_GATES = WS_VB + 32 * MiB, WS_ATT = WS_GATES + 256 * MiB, WS_P1END = WS_ATT + 160 * MiB;
constexpr size_t WS_GATED = WS_A;
constexpr size_t WS_H2 = WS_A;
constexpr size_t WS_LOGITS = 560 * MiB;
constexpr size_t WS_SHACT = 624 * MiB;
constexpr size_t WS_ACT = 656 * MiB;
constexpr size_t WS_NEED = 1084 * MiB;
constexpr int CW_COUNTS = 1024;
constexpr int MW_PSTART = 0, MW_PEND = 512, MW_CNT = 1024;

typedef unsigned short bf16;
__device__ __forceinline__ float bf2f(bf16 b) { return __uint_as_float(((unsigned)b) << 16); }
__device__ __forceinline__ bf16 f2bf(float f) { unsigned u = __float_as_uint(f); return (bf16)((u + 0x7fffu + ((u >> 16) & 1u)) >> 16); }
__device__ __forceinline__ float wave_sum(float v) {
#pragma unroll
    for (int o = 1; o < 64; o <<= 1) v += __shfl_xor(v, o);
    return v;
}
__device__ __forceinline__ float sigmoidf_(float x) { return 1.f / (1.f + __expf(-x)); }

__global__ void k_mod(const float* c, const float* w_ada, const float* b_ada, float* mod) {
    const int idx = blockIdx.x * 256 + threadIdx.x; const int b = idx / 6144, j = idx % 6144;
    float acc = 0.f;
    for (int k = 0; k < DM; ++k) { const float cv = c[b * DM + k]; acc += (cv / (1.f + __expf(-cv))) * w_ada[(size_t)k * 6144 + j]; }
    mod[idx] = acc + b_ada[j];
}
__global__ void k_tables(float* rope) {
    float* C1 = rope; float* S1 = rope + 65536; float* CR = rope + 131072; float* SR = CR + 512; float* CC = SR + 512; float* SC = CC + 1024;
    const int idx = blockIdx.x * 256 + threadIdx.x;
    if (idx < 65536) { const int t = idx >> 5, j = idx & 31; const double a = (double)t * pow(10000.0, -(double)j / 32.0); C1[idx] = (float)cos(a); S1[idx] = (float)sin(a); }
    if (idx < 512) { const int p = idx >> 4, j = idx & 15; const double a = (double)p * pow(10000.0, -(double)j / 16.0); CR[idx] = (float)cos(a); SR[idx] = (float)sin(a); }
    if (idx < 1024) { const int p = idx >> 4, j = idx & 15; const double a = (double)p * pow(10000.0, -(double)j / 16.0); CC[idx] = (float)cos(a); SC[idx] = (float)sin(a); }
}
__global__ void k_norm_rows(const float* x, const float* g, const float* mod, int i_shift, int i_scale, bf16* out) {
    const int row = blockIdx.x * 4 + (threadIdx.x >> 6), lane = threadIdx.x & 63; const int b = row / SEQ;
    const float* xr = x + (size_t)row * DM; float v[16]; float ss = 0.f;
#pragma unroll
    for (int j = 0; j < 16; ++j) { v[j] = xr[lane + 64 * j]; ss += v[j] * v[j]; }
    const float rstd = 1.f / sqrtf(wave_sum(ss) * (1.f / DM) + NORM_EPS);
    const float* sh = mod + (size_t)b * 6144 + i_shift * DM; const float* sc = mod + (size_t)b * 6144 + i_scale * DM;
#pragma unroll
    for (int j = 0; j < 16; ++j) { const int cidx = lane + 64 * j; out[(size_t)row * DM + cidx] = f2bf(v[j] * rstd * g[cidx] * (1.f + sc[cidx]) + sh[cidx]); }
}
__global__ void k_final(float* xo, const float* g) {
    const int row = blockIdx.x * 4 + (threadIdx.x >> 6), lane = threadIdx.x & 63;
    float* xr = xo + (size_t)row * DM; float v[16]; float ss = 0.f;
#pragma unroll
    for (int j = 0; j < 16; ++j) { v[j] = xr[lane + 64 * j]; ss += v[j] * v[j]; }
    const float rstd = 1.f / sqrtf(wave_sum(ss) * (1.f / DM) + NORM_EPS);
#pragma unroll
    for (int j = 0; j < 16; ++j) { const int cidx = lane + 64 * j; xr[cidx] = v[j] * rstd * g[cidx]; }
}

struct RouteTabs { const int* stok; const float* sgate; const int* pstart; const int* pend; const int* cnt; };
__device__ __forceinline__ int expert_of_slot(const RouteTabs& R, int slot, int& chunk, int& local) {
    chunk = slot / CH_SLOTS; local = slot - chunk * CH_SLOTS; const int* pe = R.pend + chunk * NEXP;
    int lo = 0, hi = NEXP;
    while (lo < hi) { const int mid = (lo + hi) >> 1; if (pe[mid] > local) hi = mid; else lo = mid + 1; }
    return lo;
}
struct AlPlain { const bf16* A; int lda; int pad;
    __device__ int group(int rt) const { return 0; }
    __device__ float load(int grp, int rt, int r, int k) const { return bf2f(A[(size_t)(rt * 64 + r) * lda + k]); } };
struct AlGather { const bf16* A; RouteTabs R; int lda; int pad;
    __device__ int group(int rt) const { int ch, loc; const int e = expert_of_slot(R, rt * 64, ch, loc); if (e >= NEXP) return -1;
        const int n = R.cnt[ch * NEXP + e]; if (loc - R.pstart[ch * NEXP + e] >= n) return -1; return e; }
    __device__ float load(int grp, int rt, int r, int k) const { const int tok = R.stok[rt * 64 + r] >> 3; return tok < 0 ? 0.f : bf2f(A[(size_t)tok * lda + k]); } };
struct AlSlot { const bf16* A; RouteTabs R;
    __device__ int group(int rt) const { int ch, loc; const int e = expert_of_slot(R, rt * 64, ch, loc); if (e >= NEXP) return -1; const int n = R.cnt[ch * NEXP + e]; if (loc - R.pstart[ch * NEXP + e] >= n) return -1; return e; }
    __device__ float load(int grp, int rt, int r, int k) const { return bf2f(A[(size_t)(rt * 64 + r) * EFF + k]); } };
struct BlPlain { const float* W; int ldb; int pad; __device__ float load(int grp, int k, int col) const { return W[(size_t)k * ldb + col]; } };
struct BlSwiglu { const float* Wg; const float* Wu; size_t estride;
    __device__ float load(int grp, int k, int col) const { const int ff = (col >> 6) * 32 + (col & 31); const float* W = (col & 32) ? Wu : Wg; return W[(size_t)grp * estride + (size_t)k * EFF + ff]; } };
struct BlExp { const float* W; size_t estride; int ldb; int pad; __device__ float load(int grp, int k, int col) const { return W[(size_t)grp * estride + (size_t)k * ldb + col]; } };

template <int K, class AL, class BL, class EP>
__global__ void __launch_bounds__(256) k_gemm64(AL al, BL bl, EP ep) {
    __shared__ float As[16][68], Bs[16][68];
    __shared__ float Ct[64][65];
    const int tid = threadIdx.x, tx = tid & 15, ty = tid >> 4, col0 = blockIdx.x * 64, rt = blockIdx.y;
    const int grp = al.group(rt); if (grp < 0) return;
    float acc[4][4];
#pragma unroll
    for (int i = 0; i < 4; ++i)
#pragma unroll
        for (int j = 0; j < 4; ++j) acc[i][j] = 0.f;
    for (int k0 = 0; k0 < K; k0 += 16) {
#pragma unroll
        for (int i = 0; i < 4; ++i) { const int e = tid + 256 * i, r = e >> 4, kk = e & 15; As[kk][r] = al.load(grp, rt, r, k0 + kk); }
#pragma unroll
        for (int i = 0; i < 4; ++i) { const int e = tid + 256 * i, kk = e >> 6, cc = e & 63; Bs[kk][cc] = bl.load(grp, k0 + kk, col0 + cc); }
        __syncthreads();
#pragma unroll
        for (int kk = 0; kk < 16; ++kk) {
            float a[4], b[4];
#pragma unroll
            for (int i = 0; i < 4; ++i) { a[i] = As[kk][ty * 4 + i]; b[i] = Bs[kk][tx * 4 + i]; }
#pragma unroll
            for (int i = 0; i < 4; ++i)
#pragma unroll
                for (int j = 0; j < 4; ++j) acc[i][j] += a[i] * b[j];
        }
        __syncthreads();
    }
#pragma unroll
    for (int i = 0; i < 4; ++i)
#pragma unroll
        for (int j = 0; j < 4; ++j) Ct[ty * 4 + i][tx * 4 + j] = acc[i][j];
    __syncthreads();
    ep(Ct, grp, rt, col0, tid);
}

struct EpP1 {
    const float* rope; const float* qn_g; const float* kn_g; const float* b_gate; unsigned char* ws;
    __device__ void operator()(const float (*Ct)[65], int grp, int rt, int col0, int tid) const {
        const int row0 = rt * 64;
        const float* C1 = rope; const float* S1 = rope + 65536; const float* CR = rope + 131072; const float* SR = CR + 512; const float* CC = SR + 512; const float* SC = CC + 1024;
        if (col0 < C_VA) {
            const bool isq = col0 < C_KA; bf16* O = (bf16*)(ws + (isq ? WS_QA : WS_KA)); const int hc = isq ? col0 : col0 - C_KA; const float sc = isq ? QSCALE : 1.f;
            for (int e = tid; e < 64 * 32; e += 256) { const int r = e >> 5, d = e & 31; const int t = (row0 + r) % SEQ;
                const float x1 = Ct[r][d], x2 = Ct[r][d + 32], c = C1[t * 32 + d], s = S1[t * 32 + d];
                O[(size_t)(row0 + r) * DILW + hc + d] = f2bf((x1 * c - x2 * s) * sc); O[(size_t)(row0 + r) * DILW + hc + d + 32] = f2bf((x2 * c + x1 * s) * sc); }
        } else if (col0 < C_QB) {
            bf16* O = (bf16*)(ws + WS_VA); const int hc = col0 - C_VA;
            for (int e = tid; e < 64 * 64; e += 256) { const int r = e >> 6, d = e & 63; O[(size_t)(row0 + r) * DILW + hc + d] = f2bf(Ct[r][d]); }
        } else if (col0 < C_VB) {
            const bool isq = col0 < C_KB; bf16* O = (bf16*)(ws + (isq ? WS_QB : WS_KB)); const int hc = isq ? col0 - C_QB : col0 - C_KB; const int ld = isq ? GQW : GKW;
            const float* g = isq ? qn_g : kn_g; const float sc = isq ? QSCALE : 1.f;
            const int r = tid >> 2, q4 = tid & 3; float ss = 0.f;
            for (int d = 0; d < 64; ++d) ss += Ct[r][d] * Ct[r][d];
            const float rstd = 1.f / sqrtf(ss * (1.f / 64.f) + NORM_EPS);
            const int t = (row0 + r) % SEQ, rp = t >> 6, cp = t & 63;
            for (int i = 0; i < 8; ++i) { const int p = q4 * 8 + i;
                const int j = p & 15, d = (p < 16) ? j : 32 + j;
                const float c = (p < 16) ? CR[rp * 16 + j] : CC[cp * 16 + j], s = (p < 16) ? SR[rp * 16 + j] : SC[cp * 16 + j];
                const float y1 = Ct[r][d] * rstd * g[d], y2 = Ct[r][d + 16] * rstd * g[d + 16];
                O[(size_t)(row0 + r) * ld + hc + d] = f2bf((y1 * c - y2 * s) * sc); O[(size_t)(row0 + r) * ld + hc + d + 16] = f2bf((y2 * c + y1 * s) * sc); }
        } else if (col0 < C_GT) {
            bf16* O = (bf16*)(ws + WS_VB); const int hc = col0 - C_VB;
            for (int e = tid; e < 64 * 64; e += 256) { const int r = e >> 6, d = e & 63; O[(size_t)(row0 + r) * GKW + hc + d] = f2bf(Ct[r][d]); }
        } else {
            bf16* O = (bf16*)(ws + WS_GATES); const int hc = col0 - C_GT;
            for (int e = tid; e < 64 * 64; e += 256) { const int r = e >> 6, d = e & 63; O[(size_t)(row0 + r) * 2048 + hc + d] = f2bf(sigmoidf_(Ct[r][d] + b_gate[hc + d])); }
        }
    }
};
struct EpYa { const bf16* gates; float* ya;
    __device__ void operator()(const float (*Ct)[65], int grp, int rt, int col0, int tid) const {
        for (int e = tid; e < 4096; e += 256) { const int r = e >> 6, d = e & 63; const size_t row = rt * 64 + r; ya[row * DM + col0 + d] = bf2f(gates[row * 2048 + col0 + d]) * Ct[r][d]; } } };
struct EpGated { const bf16* gates; const float* ya; bf16* gated;
    __device__ void operator()(const float (*Ct)[65], int grp, int rt, int col0, int tid) const {
        for (int e = tid; e < 4096; e += 256) { const int r = e >> 6, d = e & 63; const size_t row = rt * 64 + r; gated[row * DM + col0 + d] = f2bf(ya[row * DM + col0 + d] + bf2f(gates[row * 2048 + 1024 + col0 + d]) * Ct[r][d]); } } };
struct EpXmid { const float* x; const float* mod; float* xmid;
    __device__ void operator()(const float (*Ct)[65], int grp, int rt, int col0, int tid) const {
        for (int e = tid; e < 4096; e += 256) { const int r = e >> 6, d = e & 63; const size_t row = rt * 64 + r; const int b = (int)(row / SEQ);
            xmid[row * DM + col0 + d] = x[row * DM + col0 + d] + mod[(size_t)b * 6144 + 2 * DM + col0 + d] * Ct[r][d]; } } };
struct EpLogits { float* lg;
    __device__ void operator()(const float (*Ct)[65], int grp, int rt, int col0, int tid) const {
        for (int e = tid; e < 4096; e += 256) { const int r = e >> 6, d = e & 63; lg[(size_t)(rt * 64 + r) * NEXP + col0 + d] = Ct[r][d]; } } };
struct EpSwiglu { bf16* act;
    __device__ void operator()(const float (*Ct)[65], int grp, int rt, int col0, int tid) const {
        const int ff0 = (col0 >> 6) * 32;
        for (int e = tid; e < 64 * 32; e += 256) { const int r = e >> 5, j = e & 31; const float g = Ct[r][j], u = Ct[r][j + 32];
            act[(size_t)(rt * 64 + r) * EFF + ff0 + j] = f2bf(g / (1.f + __expf(-g)) * u); } } };
struct EpShDown { const float* mod; float* xo;
    __device__ void operator()(const float (*Ct)[65], int grp, int rt, int col0, int tid) const {
        for (int e = tid; e < 4096; e += 256) { const int r = e >> 6, d = e & 63; const size_t row = rt * 64 + r; const int b = (int)(row / SEQ);
            xo[row * DM + col0 + d] += mod[(size_t)b * 6144 + 5 * DM + col0 + d] * Ct[r][d]; } } };
struct EpExpDown { const float* mod; float* xo; RouteTabs R;
    __device__ void operator()(const float (*Ct)[65], int grp, int rt, int col0, int tid) const {
        for (int e = tid; e < 4096; e += 256) { const int r = e >> 6, d = e & 63; const int slot = rt * 64 + r; const int tok = R.stok[slot] >> 3; if (tok < 0) continue; const int b = tok / SEQ;
            atomicAdd(&xo[(size_t)tok * DM + col0 + d], mod[(size_t)b * 6144 + 5 * DM + col0 + d] * R.sgate[slot] * Ct[r][d]); } } };

__global__ void __launch_bounds__(64) k_gqa_naive(const bf16* QB, const bf16* KB, const bf16* VB, bf16* ATT) {
    const int h = blockIdx.y, b = blockIdx.z, t = blockIdx.x * 64 + threadIdx.x; const int kvh = h >> 2;
    const size_t row = (size_t)b * SEQ + t;
    float q[64], o[64];
#pragma unroll
    for (int d = 0; d < 64; ++d) { q[d] = bf2f(QB[row * GQW + h * 64 + d]); o[d] = 0.f; }
    float m = -1e30f, l = 0.f;
    for (int j = 0; j < SEQ; ++j) {
        const bf16* kr = KB + ((size_t)b * SEQ + j) * GKW + kvh * 64; const bf16* vr = VB + ((size_t)b * SEQ + j) * GKW + kvh * 64;
        float s = 0.f;
#pragma unroll
        for (int d = 0; d < 64; ++d) s += q[d] * bf2f(kr[d]);
        const float mn = fmaxf(m, s), corr = exp2f(m - mn), p = exp2f(s - mn);
        l = l * corr + p; m = mn;
#pragma unroll
        for (int d = 0; d < 64; ++d) o[d] = o[d] * corr + p * bf2f(vr[d]);
    }
    const float il = 1.f / l;
#pragma unroll
    for (int d = 0; d < 64; ++d) ATT[row * 1280 + 256 + h * 64 + d] = f2bf(o[d] * il);
}
__global__ void __launch_bounds__(64) k_dil_naive(const bf16* QA, const bf16* KA, const bf16* VA, bf16* ATT) {
    const int hh = blockIdx.y, b = blockIdx.z, t = blockIdx.x * 64 + threadIdx.x;
    const size_t row = (size_t)b * SEQ + t;
    float q[64], o[64];
#pragma unroll
    for (int d = 0; d < 64; ++d) o[d] = 0.f;
    float m = -1e30f, l = 0.f;
    for (int g = 0; g < 3; ++g) {
        const int dil = (g == 0) ? 1 : (g == 1) ? 4 : 16; const int hc = (g * 4 + hh) * 64;
#pragma unroll
        for (int d = 0; d < 64; ++d) q[d] = bf2f(QA[row * DILW + hc + d]);
        for (int j = -64; j <= 64; ++j) {
            const int t2 = t + j * dil; if (t2 < 0 || t2 >= SEQ) continue;
            const bf16* kr = KA + ((size_t)b * SEQ + t2) * DILW + hc; const bf16* vr = VA + ((size_t)b * SEQ + t2) * DILW + hc;
            float s = 0.f;
#pragma unroll
            for (int d = 0; d < 64; ++d) s += q[d] * bf2f(kr[d]);
            const float mn = fmaxf(m, s), corr = exp2f(m - mn), p = exp2f(s - mn);
            l = l * corr + p; m = mn;
#pragma unroll
            for (int d = 0; d < 64; ++d) o[d] = o[d] * corr + p * bf2f(vr[d]);
        }
    }
    const float il = 1.f / l;
#pragma unroll
    for (int d = 0; d < 64; ++d) ATT[row * 1280 + hh * 64 + d] = f2bf(o[d] * il);
}

__global__ void __launch_bounds__(256) k_topk(const float* logits, const float* rbias, int* IDX, float* GATEV, int* POSE, int* counts) {
    const int t = blockIdx.x * 4 + (threadIdx.x >> 6), lane = threadIdx.x & 63;
    const float4 lg = *(const float4*)(logits + (size_t)t * NEXP + 4 * lane); const float4 rb = *(const float4*)(rbias + 4 * lane);
    float s[4] = {sigmoidf_(lg.x), sigmoidf_(lg.y), sigmoidf_(lg.z), sigmoidf_(lg.w)};
    float v[4] = {s[0] + rb.x, s[1] + rb.y, s[2] + rb.z, s[3] + rb.w};
    float m1 = fmaxf(v[0], v[1]), m2 = fminf(v[0], v[1]);
    { const float a = fmaxf(v[2], v[3]), c = fminf(v[2], v[3]); const float n1 = fmaxf(m1, a); const float n2 = fmaxf(fminf(m1, a), fmaxf(m2, c)); m1 = n1; m2 = n2; }
#pragma unroll
    for (int o = 1; o < 8; o <<= 1) { const float a1 = __shfl_xor(m1, o), a2 = __shfl_xor(m2, o); const float n1 = fmaxf(m1, a1); const float n2 = fmaxf(fminf(m1, a1), fmaxf(m2, a2)); m1 = n1; m2 = n2; }
    const float gs = m1 + m2; const int grp = lane >> 3; int rank = 0;
#pragma unroll
    for (int g2 = 0; g2 < 8; ++g2) { const float o = __shfl(gs, 8 * g2); rank += (o > gs || (o == gs && g2 < grp)) ? 1 : 0; }
    const bool sel = rank < 4;
#pragma unroll
    for (int i = 0; i < 4; ++i) if (!sel) v[i] = -INFINITY;
    int myidx = 0; float mysc = 0.f; float ssum = 0.f;
    for (int k = 0; k < TOPK; ++k) {
        float bv = v[0]; int bi = 4 * lane;
#pragma unroll
        for (int i = 1; i < 4; ++i) if (v[i] > bv) { bv = v[i]; bi = 4 * lane + i; }
#pragma unroll
        for (int o = 1; o < 64; o <<= 1) { const float ov = __shfl_xor(bv, o); const int oi = __shfl_xor(bi, o); if (ov > bv || (ov == bv && oi < bi)) { bv = ov; bi = oi; } }
        const int wl = bi >> 2, wi = bi & 3;
        float sc = 0.f;
        if (lane == wl) {
#pragma unroll
            for (int i = 0; i < 4; ++i) if (i == wi) { sc = s[i]; v[i] = -INFINITY; }
        }
        sc = __shfl(sc, wl); ssum += sc;
        if (lane == k) { myidx = bi; mysc = sc; }
    }
    if (lane < TOPK) {
        const int chunk = t / CH_TOK;
        IDX[(size_t)t * TOPK + lane] = myidx; GATEV[(size_t)t * TOPK + lane] = mysc / ssum * 2.5f;
        POSE[(size_t)t * TOPK + lane] = atomicAdd(&counts[chunk * NEXP + myidx], 1);
    }
}
__global__ void k_scan(const int* counts, int* misc) {
    if (threadIdx.x < NCHUNK) { const int c = threadIdx.x; int run = 0;
        for (int e = 0; e < NEXP; ++e) { const int n = counts[c * NEXP + e]; misc[MW_PSTART + c * NEXP + e] = run; run += (n + 255) & ~255; misc[MW_PEND + c * NEXP + e] = run; misc[MW_CNT + c * NEXP + e] = n; } }
}
__global__ void k_scatter(const int* IDX, const float* GATEV, const int* POSE, const int* misc, int* STOK, float* SGATE) {
    const int i = blockIdx.x * 256 + threadIdx.x; const int t = i >> 3; const int c = t / CH_TOK; const int e = IDX[i];
    const int slot = c * CH_SLOTS + misc[MW_PSTART + c * NEXP + e] + POSE[i];
    STOK[slot] = i; SGATE[slot] = GATEV[i];
}

__device__ __forceinline__ int hw_tid(int wave) { int l_; asm volatile("v_mbcnt_lo_u32_b32 %0, -1, 0\n\tv_mbcnt_hi_u32_b32 %0, -1, %0" : "=v"(l_)); return (wave << 6) | l_; }
namespace pg8 {
#define PG8_LAS __attribute__((address_space(3)))
typedef unsigned short bf16_t;
typedef short bf16x8 __attribute__((ext_vector_type(8)));
typedef float f32x4 __attribute__((ext_vector_type(4)));
typedef unsigned u32x4 __attribute__((ext_vector_type(4)));
typedef unsigned u32x2 __attribute__((ext_vector_type(2)));
constexpr int BM = 256, BK = 64, HALF = 128, HTB = HALF * BK * 2, STAGE_BYTES = 8 * HTB, NXCD = 8, WGM = 8;
__host__ __device__ __forceinline__ int lds_byte(int r, int c) { const int st = (r >> 4) * 2 + (c >> 5), rr = r & 15, cc = c & 31, ob = rr * 64 + cc * 2; return st * 1024 + (ob ^ (((ob >> 9) & 1) << 5)); }
__host__ __device__ __forceinline__ void stage_rc(int b, int& R, int& C) { const int st = b / 1024, sb = b % 1024, swz = sb ^ (((sb >> 9) & 1) << 5); R = (st >> 1) * 16 + swz / 64; C = (st & 1) * 32 + (swz % 64) / 2; }
__host__ __device__ __forceinline__ int perm32(int rho) { const int n = rho >> 4, i = rho & 15; return 8 * (i >> 2) + 4 * n + (i & 3); }
struct Unit { int pm, pn; };
struct Gemm { const bf16_t* A; const bf16_t* Bt; int M, N, K, lda, ldb; };
struct StaticOrder {
    int nM, nN, nwg, G, c;
    __host__ __device__ void init(int M, int N, int G_, int c_) { nM = M / BM; nN = N / BM; nwg = nM * nN; G = G_; c = c_; }
    __host__ __device__ bool next(int i, Unit& u) const {
        const long L = (long)i * G + c; if (L >= nwg) return false;
        int wgid = (int)L; { const int q = nwg / NXCD, r = nwg % NXCD, xcd = wgid % NXCD, off = wgid / NXCD; wgid = (xcd < r ? xcd * (q + 1) : r * (q + 1) + (xcd - r) * q) + off; }
        const int nig = WGM * nN, gid = wgid / nig, fm = gid * WGM, gsz = (nM - fm) < WGM ? (nM - fm) : WGM;
        u.pm = fm + ((wgid % nig) % gsz); u.pn = (wgid % nig) / gsz; return true;
    }
    __device__ __forceinline__ void a_ready(const Unit&) const {}
    __device__ __forceinline__ void done(const Unit&) const {}
};
__device__ __forceinline__ unsigned cvt_pk_bf16(float lo, float hi) { unsigned r; asm volatile("v_cvt_pk_bf16_f32 %0, %1, %2" : "=v"(r) : "v"(lo), "v"(hi)); return r; }

template <class T, class = void> struct epi_f8 { static constexpr bool v = false; };
template <class T> struct epi_f8<T, decltype((void)T::F8)> { static constexpr bool v = T::F8; };
template <class Epi, class Sched>
__device__ __forceinline__ void gemm_phase(PG8_LAS unsigned char* lds, const Gemm g, const Sched& S, const Epi& E, const int wv) {
    int tid = hw_tid(wv);
    const int wid = __builtin_amdgcn_readfirstlane(tid >> 6), lane = tid & 63, wr = wid >> 2, wc = wid & 3, fr = lane & 15, fq = lane >> 4;
    constexpr bool F8 = epi_f8<Epi>::v; constexpr int ES = F8 ? 1 : 2;
    const int K = g.K, nt = K * ES / (BK * 2);
    unsigned voffA[2], voffB[2];
#pragma unroll
    for (int i = 0; i < 2; ++i) { int R, C; stage_rc(tid * 16 + i * 8192, R, C); const int Rb = Epi::PERM ? ((R & ~31) + perm32(R & 31)) : R;
        voffA[i] = (unsigned)(R * g.lda * ES + C * 2); voffB[i] = (unsigned)(Rb * g.ldb * ES + C * 2); }
    const size_t kstep = (size_t)(BK * 2);
    const size_t hstepA = (size_t)HALF * g.lda * ES, hstepB = (size_t)HALF * g.ldb * ES;
    const size_t tstepA = 2 * hstepA, tstepB = 2 * hstepB;
    const unsigned ldsw = (unsigned)wid * 1024u;
    const int aoff = lds_byte(wr * 64 + fr, fq * 8), boff = lds_byte(wc * 32 + fr, fq * 8);
#define PG8_SA(b, h) (((b) * 2 + (h)) * HTB)
#define PG8_SB(b, h) ((4 + (b) * 2 + (h)) * HTB)
#define PG8_STAGE(bufoff, gbase, voff) do { _Pragma("unroll") for (int _i = 0; _i < 2; ++_i) { unsigned o_ = (voff)[_i]; if constexpr (F8) asm volatile("" : "+v"(o_));   \
        __builtin_amdgcn_global_load_lds((const unsigned*)((const char*)(gbase) + o_), (PG8_LAS unsigned*)(lds + (bufoff) + ldsw + _i * 8192), 16, 0, 0); } } while (0)
#define PG8_LDA(dst, b, h) do { _Pragma("unroll") for (int m = 0; m < 4; ++m) _Pragma("unroll") for (int k = 0; k < 2; ++k) dst[m][k] = *(const PG8_LAS bf16x8*)(lds + PG8_SA(b, h) + aoff + m * 2048 + k * 1024); } while (0)
#define PG8_LDB(dst, b, h) do { _Pragma("unroll") for (int n = 0; n < 2; ++n) _Pragma("unroll") for (int k = 0; k < 2; ++k) dst[n][k] = *(const PG8_LAS bf16x8*)(lds + PG8_SB(b, h) + boff + n * 2048 + k * 1024); } while (0)
    typedef int i32x8_t __attribute__((ext_vector_type(8))); typedef int i32x4_t __attribute__((ext_vector_type(4)));
#define PG8_CAT(lo, hi) __builtin_shufflevector(__builtin_bit_cast(i32x4_t, lo), __builtin_bit_cast(i32x4_t, hi), 0, 1, 2, 3, 4, 5, 6, 7)
#define PG8_MMA(ai, bj, At, Bt) do { __builtin_amdgcn_s_setprio(1); _Pragma("unroll") for (int m = 0; m < 4; ++m) _Pragma("unroll") for (int n = 0; n < 2; ++n) { \
        if constexpr (F8) acc[ai][bj][m][n] = __builtin_amdgcn_mfma_scale_f32_16x16x128_f8f6f4(PG8_CAT(Bt[n][0], Bt[n][1]), PG8_CAT(At[m][0], At[m][1]), acc[ai][bj][m][n], 0, 0, 0, 0x7F7F7F7F, 0, 0x7F7F7F7F); \
        else { _Pragma("unroll") for (int k = 0; k < 2; ++k) acc[ai][bj][m][n] = __builtin_amdgcn_mfma_f32_16x16x32_bf16(Bt[n][k], At[m][k], acc[ai][bj][m][n], 0, 0, 0); } } \
        __builtin_amdgcn_s_setprio(0); } while (0)
#define PG8_WAIT_V(n) asm volatile("s_waitcnt vmcnt(" #n ")" ::: "memory")
#define PG8_WAIT_L(n) asm volatile("s_waitcnt lgkmcnt(" #n ")" ::: "memory")
#define PG8_BAR __builtin_amdgcn_s_barrier()
#define PG8_SCHED __builtin_amdgcn_sched_barrier(0)
    Unit cur, nxt; int ui = 0;
    if (!S.next(0, cur)) return;
    f32x4 acc[2][2][4][2];
#pragma unroll
    for (int a = 0; a < 2; ++a)
#pragma unroll
        for (int b = 0; b < 2; ++b)
#pragma unroll
            for (int m = 0; m < 4; ++m)
#pragma unroll
                for (int n = 0; n < 2; ++n) acc[a][b][m][n] = (f32x4){0.f, 0.f, 0.f, 0.f};
    bf16x8 At[4][2], B0[2][2], B1[2][2];
    const char* cA = (const char*)g.A + (size_t)cur.pm * tstepA; const char* cB = (const char*)g.Bt + (size_t)cur.pn * tstepB;
    S.a_ready(cur);
    PG8_STAGE(PG8_SB(0, 0), cB, voffB); PG8_STAGE(PG8_SB(0, 1), cB + hstepB, voffB); PG8_STAGE(PG8_SA(0, 0), cA, voffA); PG8_STAGE(PG8_SA(0, 1), cA + hstepA, voffA);
    if (wr == 1) PG8_BAR;
    PG8_WAIT_V(2); PG8_BAR;
    PG8_STAGE(PG8_SB(1, 0), cB + kstep, voffB); PG8_STAGE(PG8_SA(1, 0), cA + kstep, voffA); PG8_STAGE(PG8_SB(1, 1), cB + hstepB + kstep, voffB);
    PG8_WAIT_V(6); PG8_BAR;
    for (;;) {
        const bool has_next = S.next(ui + 1, nxt);
        const char* nA = has_next ? (const char*)g.A + (size_t)nxt.pm * tstepA : cA; const char* nB = has_next ? (const char*)g.Bt + (size_t)nxt.pn * tstepB : cB;
#pragma nounroll
        for (int t = 0; t < nt; t += 2) {
            const bool last = (t == nt - 2);
            const char* a1 = cA + (size_t)(t + 1) * kstep;
            const char* a2 = last ? nA : cA + (size_t)(t + 2) * kstep; const char* b2 = last ? nB : cB + (size_t)(t + 2) * kstep;
            const char* a3 = a2 + kstep; const char* b3 = b2 + kstep;
            if (last && has_next) S.a_ready(nxt);
            if constexpr (Epi::HOOK_T >= 0) { if (t == Epi::HOOK_T) E.hook(acc, cur, wr, wc, fr, fq); }
            PG8_LDB(B0, 0, 0); PG8_LDB(B1, 0, 1); PG8_SCHED; PG8_LDA(At, 0, 0); PG8_STAGE(PG8_SA(1, 1), a1 + hstepA, voffA);
            PG8_WAIT_V(8); PG8_WAIT_L(0); PG8_BAR; PG8_MMA(0, 0, At, B0); PG8_MMA(0, 1, At, B1); PG8_BAR; PG8_SCHED;
            PG8_LDA(At, 0, 1); PG8_STAGE(PG8_SB(0, 0), b2, voffB); PG8_STAGE(PG8_SB(0, 1), b2 + hstepB, voffB); PG8_STAGE(PG8_SA(0, 0), a2, voffA);
            PG8_WAIT_V(8); PG8_WAIT_L(0); PG8_BAR; PG8_MMA(1, 0, At, B0); PG8_MMA(1, 1, At, B1); PG8_BAR; PG8_SCHED;
            PG8_LDB(B0, 1, 0); PG8_LDB(B1, 1, 1); PG8_SCHED; PG8_LDA(At, 1, 0); PG8_STAGE(PG8_SA(0, 1), a2 + hstepA, voffA);
            PG8_WAIT_V(8); PG8_WAIT_L(0); PG8_BAR; PG8_MMA(0, 0, At, B0); PG8_MMA(0, 1, At, B1); PG8_BAR; PG8_SCHED;
            PG8_LDA(At, 1, 1); PG8_STAGE(PG8_SB(1, 0), b3, voffB); PG8_STAGE(PG8_SB(1, 1), b3 + hstepB, voffB); PG8_STAGE(PG8_SA(1, 0), a3, voffA);
            PG8_WAIT_V(8); PG8_WAIT_L(0); PG8_BAR; PG8_MMA(1, 0, At, B0); PG8_MMA(1, 1, At, B1); PG8_BAR; PG8_SCHED;
        }
        if (wr == 0) PG8_BAR;
        { int t_ = tid; asm volatile("" : "+v"(t_)); E(acc, cur, wr, wc, t_ & 15, (t_ >> 4) & 3); } S.done(cur);
        if (!has_next) break;
#pragma unroll
        for (int a = 0; a < 2; ++a)
#pragma unroll
            for (int b = 0; b < 2; ++b)
#pragma unroll
                for (int m = 0; m < 4; ++m)
#pragma unroll
                    for (int n = 0; n < 2; ++n) acc[a][b][m][n] = (f32x4){0.f, 0.f, 0.f, 0.f};
        cur = nxt; cA = nA; cB = nB; ++ui;
        if (wr == 1) PG8_BAR;
    }
    PG8_WAIT_V(0);
    PG8_BAR;
#undef PG8_SA
#undef PG8_SB
#undef PG8_STAGE
#undef PG8_LDA
#undef PG8_LDB
#undef PG8_MMA
#undef PG8_CAT
#undef PG8_WAIT_V
#undef PG8_WAIT_L
#undef PG8_BAR
#undef PG8_SCHED
}
}

#include <hip/hip_bf16.h>
namespace attn_body {
using bf16=__hip_bfloat16;
using bf16x8=__attribute__((ext_vector_type(8)))short;
using s16x4=__attribute__((ext_vector_type(4)))short;
using f32x16=__attribute__((ext_vector_type(16)))float;
using u32x4=__attribute__((ext_vector_type(4)))unsigned;
constexpr int BATCH=32,NHEAD=16,SEQ=2048,D=64,QP=1024,KVP=256,OP=1280,OCOL=256;
constexpr int NW=8,QBLK=32,QB=QBLK*NW,KVBLK=64,NQB=SEQ/QB;
constexpr int ATTN_UNIT_ROWS=QB;
__device__ __forceinline__ int crow(int r,int hi){return (r&3)+8*(r>>2)+4*hi;}
#define SBAR() __builtin_amdgcn_sched_barrier(0)
__device__ __forceinline__ void cmask(f32x16&p0,f32x16&p1,int jb,int qrel,int hi){
  const float NEG=-INFINITY; int kb=64*jb+4*hi;
  #pragma unroll
  for(int r=0;r<16;++r){int kv=kb+(r&3)+8*(r>>2); if(kv>qrel)p0[r]=NEG; if(kv+32>qrel)p1[r]=NEG;}
}

constexpr int NSLOT=3, SLOTB=8192;
constexpr int LDS_K=0, LDS_V=NSLOT*SLOTB, LDS_WS=2*NSLOT*SLOTB, LDS_OST=LDS_WS+NW*64*4, LDS_BYTES=LDS_OST+NW*4096;
constexpr float C2=0.125f*1.4426950408889634f;
__device__ __forceinline__ void glds16(const void*gsrc,unsigned lds_dst){unsigned keep;
  asm volatile("s_mov_b32 %0, m0\n\ts_mov_b32 m0, %2\n\ts_nop 0\n\tglobal_load_lds_dwordx4 %1, off\n\ts_mov_b32 m0, %0":"=&s"(keep):"v"(gsrc),"s"(lds_dst):"memory");}
__device__ __forceinline__ float max3f(float a,float b,float c){float r;asm("v_max3_f32 %0, %1, %2, %3":"=v"(r):"v"(a),"v"(b),"v"(c));return r;}
__device__ __forceinline__ float max2f(float a,float b){float r;asm("v_max_f32_e32 %0, %1, %2":"=v"(r):"v"(a),"v"(b));return r;}
__device__ __forceinline__ float fadd_s(float a,float b){float r;asm("v_add_f32_e32 %0, %1, %2":"=v"(r):"v"(a),"v"(b));return r;}
__device__ __forceinline__ float fsub_s(float a,float b){float r;asm("v_sub_f32_e32 %0, %1, %2":"=v"(r):"v"(a),"v"(b));return r;}
typedef float f32x2_t __attribute__((ext_vector_type(2))); typedef __bf16 bf16x2_t __attribute__((ext_vector_type(2)));
__device__ __forceinline__ unsigned cvtpk_s(float lo,float hi){f32x2_t v={lo,hi};bf16x2_t b=__builtin_convertvector(v,bf16x2_t);return __builtin_bit_cast(unsigned,b);}
#define WAIT_BAR(N) asm volatile("s_waitcnt vmcnt(" #N ") lgkmcnt(0)\n\ts_barrier":::"memory")

__device__ __forceinline__ void qkt(f32x16&p0,f32x16&p1,const char*Kslot,const bf16x8*qr,const f32x16&negm,int r32,int hi){
  const char*kb=Kslot+hi*1024+r32*16;
  #pragma unroll
  for(int d0=0;d0<4;++d0){
    const bf16x8 b0=*reinterpret_cast<const bf16x8*>(kb+d0*2048);
    const bf16x8 b1=*reinterpret_cast<const bf16x8*>(kb+d0*2048+512);
    if(d0==0){p0=__builtin_amdgcn_mfma_f32_32x32x16_bf16(b0,qr[0],negm,0,0,0);p1=__builtin_amdgcn_mfma_f32_32x32x16_bf16(b1,qr[0],negm,0,0,0);}
    else{p0=__builtin_amdgcn_mfma_f32_32x32x16_bf16(b0,qr[d0],p0,0,0,0);p1=__builtin_amdgcn_mfma_f32_32x32x16_bf16(b1,qr[d0],p1,0,0,0);}}
}
typedef __attribute__((address_space(3))) const char* lds_cptr;
typedef short v4i16_t __attribute__((ext_vector_type(4)));
__device__ __forceinline__ void kload8(bf16x8*kf,lds_cptr kp){
  kf[0]=*(const __attribute__((address_space(3))) bf16x8*)(kp);      kf[1]=*(const __attribute__((address_space(3))) bf16x8*)(kp+512);
  kf[2]=*(const __attribute__((address_space(3))) bf16x8*)(kp+2048); kf[3]=*(const __attribute__((address_space(3))) bf16x8*)(kp+2560);
  kf[4]=*(const __attribute__((address_space(3))) bf16x8*)(kp+4096); kf[5]=*(const __attribute__((address_space(3))) bf16x8*)(kp+4608);
  kf[6]=*(const __attribute__((address_space(3))) bf16x8*)(kp+6144); kf[7]=*(const __attribute__((address_space(3))) bf16x8*)(kp+6656);
}
__device__ __forceinline__ void kload2(bf16x8*kf,lds_cptr kp,int j){ kf[2*j]=*(const __attribute__((address_space(3))) bf16x8*)(kp+j*2048); kf[2*j+1]=*(const __attribute__((address_space(3))) bf16x8*)(kp+j*2048+512); }
__device__ __forceinline__ s16x4 vtr(lds_cptr p){ return __builtin_bit_cast(s16x4,__builtin_amdgcn_ds_read_tr16_b64_v4i16((__attribute__((address_space(3))) v4i16_t*)p)); }
__device__ __forceinline__ float rowmax(const f32x16&p0,const f32x16&p1){
  float a=max3f(p0[0],p0[1],p1[0]),b=max3f(p0[2],p0[3],p1[1]);a=max3f(a,p1[2],p1[3]);
  #pragma unroll
  for(int r=4;r<16;r+=4){a=max3f(a,p0[r],p0[r+1]);b=max3f(b,p0[r+2],p0[r+3]);a=max3f(a,p1[r],p1[r+1]);b=max3f(b,p1[r+2],p1[r+3]);}
  const float m=max2f(a,b);
  auto rr=__builtin_amdgcn_permlane32_swap(__float_as_uint(m),__float_as_uint(m),false,false);
  return max2f(__uint_as_float(rr[0]),__uint_as_float(rr[1]));
}
__device__ __forceinline__ void pv(f32x16*o,int vb,bf16x8 pa0,bf16x8 pa1,bf16x8 pa2,bf16x8 pa3){
  #pragma unroll
  for(int d0=0;d0<2;++d0){s16x4 lo[4],hi[4];
    #pragma unroll
    for(int ks=0;ks<4;++ks){
      asm volatile("ds_read_b64_tr_b16 %0,%1 offset:%c2":"=&v"(lo[ks]):"v"(vb),"i"(d0*4096+ks*1024):"memory");
      asm volatile("ds_read_b64_tr_b16 %0,%1 offset:%c2":"=&v"(hi[ks]):"v"(vb),"i"(d0*4096+ks*1024+512):"memory");}
    asm volatile("s_waitcnt lgkmcnt(0)":::"memory");SBAR();
    #define PK(k) (bf16x8){lo[k][0],lo[k][1],lo[k][2],lo[k][3],hi[k][0],hi[k][1],hi[k][2],hi[k][3]}
    o[d0]=__builtin_amdgcn_mfma_f32_32x32x16_bf16(pa0,PK(0),o[d0],0,0,0);
    o[d0]=__builtin_amdgcn_mfma_f32_32x32x16_bf16(pa1,PK(1),o[d0],0,0,0);
    o[d0]=__builtin_amdgcn_mfma_f32_32x32x16_bf16(pa2,PK(2),o[d0],0,0,0);
    o[d0]=__builtin_amdgcn_mfma_f32_32x32x16_bf16(pa3,PK(3),o[d0],0,0,0);
    #undef PK
  }
}

#ifndef ATTN_STORE16
#define ATTN_STORE16(p,v) (*(u32x4*)(p)=(v))
#endif
template<int THRL> __device__ __forceinline__ void attn_unit(int b,int h,int qb,const bf16*Q,const bf16*__restrict__ K,const bf16*__restrict__ V,bf16*O,char*shm,const int wv){
  const int tid=hw_tid(wv),lane=tid&63,r32=lane&31,hi=lane>>5; const int wid=wv;
  const long rowbase=(long)b*SEQ; const int q0=qb*QB;
  const bf16*Qw=Q+(rowbase+q0+wid*QBLK)*QP+h*D;
  const bf16*Kh=K+rowbase*KVP+(h>>2)*D,*Vh=V+rowbase*KVP+(h>>2)*D;
  const unsigned lds0=(unsigned)(uintptr_t)shm;
  float*wsf=(float*)(shm+LDS_WS)+wid*64;
  const bf16*ksrc=Kh+(long)lane*KVP+wid*8;
  const bf16*vsrc=Vh+(long)(16*(wid&3)+(lane>>2))*KVP+(wid>>2)*32+(lane&3)*8;
  const unsigned kdst=lds0+LDS_K+wid*1024, vdst=lds0+LDS_V+wid*1024;
  #define DMA_K(t,slot) glds16(ksrc+(long)(t)*KVBLK*KVP,(unsigned)__builtin_amdgcn_readfirstlane(kdst+(slot)))
  #define DMA_V(t,slot) glds16(vsrc+(long)(t)*KVBLK*KVP,(unsigned)__builtin_amdgcn_readfirstlane(vdst+(slot)))
  const int vb0=(int)(lds0+LDS_V)+((lane>>4)&1)*32+(lane&3)*8+(4*hi+((lane&15)>>2))*64;
  const char*Kbase=shm+LDS_K; bf16x8 kf[8];
  const lds_cptr shm3=(lds_cptr)shm; const lds_cptr kp0=shm3+LDS_K+hi*1024+r32*16; const lds_cptr vp0=shm3+LDS_V+((lane>>4)&1)*32+(lane&3)*8+(4*hi+((lane&15)>>2))*64;
  constexpr int NT=SEQ/KVBLK;
  DMA_K(0,0);DMA_V(0,0);DMA_K(1,SLOTB);
  bf16x8 qr[4];
  #pragma unroll
  for(int d0=0;d0<4;++d0)qr[d0]=*reinterpret_cast<const bf16x8*>(&Qw[(long)r32*QP+d0*16+hi*8]);
  float mhat=0.f,l_reg=0.f;f32x16 o[2];o[0]=f32x16{};o[1]=f32x16{};f32x16 negm=f32x16{};asm volatile("":"+v"(negm));
  (void)0;
  #define CMASK(P0,P1,t) do{}while(0)
  bool resc=false;
  #define START(P0,P1) do{ const float rm=rowmax(P0,P1); resc=false; \
    { const float dl=rm; mhat=fadd_s(mhat,dl); \
      _Pragma("unroll") for(int r=0;r<16;++r){P0[r]=fsub_s(P0[r],dl);P1[r]=fsub_s(P1[r],dl);} \
      _Pragma("unroll") for(int r=0;r<16;++r)negm[r]=-mhat; asm volatile("":"+v"(negm)); } \
    _Pragma("unroll") for(int r=0;r<16;++r)P0[r]=__builtin_amdgcn_exp2f(P0[r]); }while(0)
  #define RESC() do{ if(resc){ asm volatile("s_waitcnt lgkmcnt(0)":::"memory"); \
      _Pragma("unroll") for(int d_=0;d_<2;++d_) _Pragma("unroll") for(int r=0;r<16;++r)o[d_][r]*=wsf[crow(r,hi)]; } }while(0)
  f32x16 pA0,pA1,pB0,pB1;
  int sl_prev=0,sl_cur=0,sl_next=SLOTB;
  #define ROT() do{sl_prev=sl_cur;sl_cur=sl_next;sl_next=(sl_next==(NSLOT-1)*SLOTB)?0:sl_next+SLOTB;}while(0)
  DMA_K(2,2*SLOTB);
  WAIT_BAR(3);
  qkt(pA0,pA1,Kbase,qr,negm,r32,hi);asm volatile("s_nop 15\n\ts_nop 7":"+v"(pA0),"+v"(pA1));CMASK(pA0,pA1,0);
  START(pA0,pA1);
  _Pragma("unroll") for(int r=0;r<16;++r)pA1[r]=__builtin_amdgcn_exp2f(pA1[r]);
  WAIT_BAR(0);
  DMA_K(3,0);DMA_V(1,SLOTB);
  ROT();
  kload8(kf,kp0+sl_cur);
  WAIT_BAR(2);
  s16x4 vlo[8],vhi[8]; u32x4 pw0,pw1,pw2,pw3;
  #define PKW(P,B) cvtpk_s(P[B],P[B+1])
  #define PAF(k) __builtin_bit_cast(bf16x8,pw##k)
  #define VFR(i) (bf16x8){vlo[i][0],vlo[i][1],vlo[i][2],vlo[i][3],vhi[i][0],vhi[i][1],vhi[i][2],vhi[i][3]}
  #define PIN(x) asm volatile("":"+v"(x))
  #define MX3(a,b,c) __builtin_fmaxf(__builtin_fmaxf((a),(b)),(c))
  #define GAPA(MF,A0,A1,A2,A3,W0,W1,PW) do{ MF; sacc+=A0; sacc+=A1; sacc+=A2; sacc+=A3; PIN(sacc); W0; W1; PIN(PW); SBAR(); }while(0)
  #define EX(v) __builtin_amdgcn_exp2f(v)
  #define GAPB(MF,X,B) do{ MF; X[B]=EX(X[B]); X[B+1]=EX(X[B+1]); X[B+2]=EX(X[B+2]); X[B+3]=EX(X[B+3]); PIN(X); SBAR(); }while(0)
  #define VRD(i) do{ vlo[i]=vtr(vp_+(((i)>>2)*4096+((i)&3)*1024)); vhi[i]=vtr(vp_+(((i)>>2)*4096+((i)&3)*1024+512)); }while(0)
  #define KRD(G,j) do{ if(G){ kload2(kf,kp0+sl_next,j); SBAR(); } }while(0)
  #define STEP(C0,C1,P0,P1,t,GK,GV,GL) do{ SBAR(); \
    const lds_cptr vp_=vp0+sl_prev; \
    VRD(0); SBAR(); float sacc=(P0[0]+P0[1]); \
    GAPA(C0=__builtin_amdgcn_mfma_f32_32x32x16_bf16(kf[0],qr[0],negm,0,0,0), P0[2],P0[3],P0[4],P0[5],     pw0[0]=PKW(P0,0), pw0[1]=PKW(P0,2), pw0); \
    VRD(4); SBAR(); GAPA(C1=__builtin_amdgcn_mfma_f32_32x32x16_bf16(kf[1],qr[0],negm,0,0,0), P0[6],P0[7],P0[8],P0[9],     pw0[2]=PKW(P0,4), pw0[3]=PKW(P0,6), pw0); \
    VRD(1); SBAR(); GAPA(C0=__builtin_amdgcn_mfma_f32_32x32x16_bf16(kf[2],qr[1],C0,0,0,0),   P0[10],P0[11],P0[12],P0[13], pw1[0]=PKW(P0,8), pw1[1]=PKW(P0,10), pw1); \
    VRD(5); SBAR(); GAPA(C1=__builtin_amdgcn_mfma_f32_32x32x16_bf16(kf[3],qr[1],C1,0,0,0),   P0[14],P0[15],P1[0],P1[1],   pw1[2]=PKW(P0,12),pw1[3]=PKW(P0,14), pw1); \
    VRD(2); SBAR(); GAPA(C0=__builtin_amdgcn_mfma_f32_32x32x16_bf16(kf[4],qr[2],C0,0,0,0),   P1[2],P1[3],P1[4],P1[5],     pw2[0]=PKW(P1,0), pw2[1]=PKW(P1,2), pw2); \
    VRD(6); SBAR(); GAPA(C1=__builtin_amdgcn_mfma_f32_32x32x16_bf16(kf[5],qr[2],C1,0,0,0),   P1[6],P1[7],P1[8],P1[9],     pw2[2]=PKW(P1,4), pw2[3]=PKW(P1,6), pw2); \
    VRD(3); SBAR(); GAPA(C0=__builtin_amdgcn_mfma_f32_32x32x16_bf16(kf[6],qr[3],C0,0,0,0),   P1[10],P1[11],P1[12],P1[13], pw3[0]=PKW(P1,8), pw3[1]=PKW(P1,10), pw3); \
    VRD(7); SBAR(); GAPA(C1=__builtin_amdgcn_mfma_f32_32x32x16_bf16(kf[7],qr[3],C1,0,0,0),   P1[14],P1[15],0.f,0.f,       pw3[2]=PKW(P1,12),pw3[3]=PKW(P1,14), pw3); \
    l_reg+=sacc; \
    if(GK){DMA_K((t)+3,sl_cur);} if(GV){DMA_V((t)+1,sl_next);} \
    CMASK(C0,C1,t); \
    { float a=MX3(C0[0],C0[1],C1[0]),b=MX3(C0[2],C0[3],C1[1]); a=MX3(a,C1[2],C1[3]); \
      _Pragma("unroll") for(int r=4;r<16;r+=4){a=MX3(a,C0[r],C0[r+1]);b=MX3(b,C0[r+2],C0[r+3]);a=MX3(a,C1[r],C1[r+1]);b=MX3(b,C1[r+2],C1[r+3]);} \
      float rm=__builtin_fmaxf(a,b); { auto rr=__builtin_amdgcn_permlane32_swap(__float_as_uint(rm),__float_as_uint(rm),false,false); rm=__builtin_fmaxf(__uint_as_float(rr[0]),__uint_as_float(rr[1])); } \
      resc=false; \
      if(__builtin_expect(__any(rm>(float)THRL),0)){ const float dl=__builtin_fmaxf(rm,0.f); mhat+=dl; \
        _Pragma("unroll") for(int r=0;r<16;++r){C0[r]-=dl;C1[r]-=dl;} \
        _Pragma("unroll") for(int r=0;r<16;++r)negm[r]=-mhat; asm volatile("":"+v"(negm)); \
        const float f=__builtin_amdgcn_exp2f(-dl); l_reg*=f; if(hi==0)wsf[r32]=f; resc=true; } } \
    SBAR(); \
    GAPB(o[0]=__builtin_amdgcn_mfma_f32_32x32x16_bf16(PAF(0),VFR(0),o[0],0,0,0), C0,0); \
    GAPB(o[1]=__builtin_amdgcn_mfma_f32_32x32x16_bf16(PAF(0),VFR(4),o[1],0,0,0), C0,4); \
    KRD(GL,0); GAPB(o[0]=__builtin_amdgcn_mfma_f32_32x32x16_bf16(PAF(1),VFR(1),o[0],0,0,0), C0,8); \
    KRD(GL,1); GAPB(o[1]=__builtin_amdgcn_mfma_f32_32x32x16_bf16(PAF(1),VFR(5),o[1],0,0,0), C0,12); \
    KRD(GL,2); GAPB(o[0]=__builtin_amdgcn_mfma_f32_32x32x16_bf16(PAF(2),VFR(2),o[0],0,0,0), C1,0); \
    KRD(GL,3); GAPB(o[1]=__builtin_amdgcn_mfma_f32_32x32x16_bf16(PAF(2),VFR(6),o[1],0,0,0), C1,4); \
    GAPB(o[0]=__builtin_amdgcn_mfma_f32_32x32x16_bf16(PAF(3),VFR(3),o[0],0,0,0), C1,8); \
    GAPB(o[1]=__builtin_amdgcn_mfma_f32_32x32x16_bf16(PAF(3),VFR(7),o[1],0,0,0), C1,12); \
    }while(0)
  int t=1;
  #undef CMASK
  #define CMASK(P0,P1,t) do{}while(0)
  for(;t+5<NT;t+=2){
    STEP(pB0,pB1,pA0,pA1,t,true,true,true);     WAIT_BAR(2); RESC(); ROT();
    STEP(pA0,pA1,pB0,pB1,t+1,true,true,true);   WAIT_BAR(2); RESC(); ROT();
  }
  #define ENDW(tt) do{ if((tt)+3<NT){WAIT_BAR(2);} else if((tt)+2<NT){WAIT_BAR(1);} else {WAIT_BAR(0);} }while(0)
  for(;t+1<NT;t+=2){
    STEP(pB0,pB1,pA0,pA1,t,(t+3<NT),(t+1<NT),(t+1<NT));       ENDW(t);   RESC(); ROT();
    STEP(pA0,pA1,pB0,pB1,t+1,(t+4<NT),(t+2<NT),(t+2<NT));     ENDW(t+1); RESC(); ROT();
  }
  STEP(pB0,pB1,pA0,pA1,NT-1,false,false,false); RESC();
  { float sacc=pB0[0]+pB0[1]; _Pragma("unroll") for(int r=2;r<16;++r)sacc+=pB0[r]; _Pragma("unroll") for(int r=0;r<16;++r)sacc+=pB1[r]; l_reg+=sacc;
    pw0=(u32x4){PKW(pB0,0),PKW(pB0,2),PKW(pB0,4),PKW(pB0,6)};pw1=(u32x4){PKW(pB0,8),PKW(pB0,10),PKW(pB0,12),PKW(pB0,14)};pw2=(u32x4){PKW(pB1,0),PKW(pB1,2),PKW(pB1,4),PKW(pB1,6)};pw3=(u32x4){PKW(pB1,8),PKW(pB1,10),PKW(pB1,12),PKW(pB1,14)};
    SBAR(); pv(o,vb0+sl_cur,PAF(0),PAF(1),PAF(2),PAF(3)); }
  #undef PKW
  #undef PAF
  #undef VFR
  #undef PIN
  #undef MX3
  #undef GAPA
  #undef GAPB
  #undef EX
  #undef VRD
  #undef KRD
  #undef STEP
  #undef ENDW
  {auto rr=__builtin_amdgcn_permlane32_swap(__float_as_uint(l_reg),__float_as_uint(l_reg),false,false);l_reg=__uint_as_float(rr[0])+__uint_as_float(rr[1]);}
  if(hi==0)wsf[32+r32]=l_reg;asm volatile("s_waitcnt lgkmcnt(0)":::"memory");
  float rli[16];
  #pragma unroll
  for(int r=0;r<16;++r)rli[r]=__builtin_amdgcn_rcpf(wsf[32+crow(r,hi)]);
  unsigned char*Ow=(unsigned char*)O+((rowbase+q0+wid*QBLK)*OP+OCOL+h*D);
  { bf16*stg=(bf16*)(shm+LDS_OST)+wid*2048;
    #pragma unroll
    for(int r=0;r<16;++r){const int orow=crow(r,hi);
      #pragma unroll
      for(int d0=0;d0<2;++d0)stg[orow*64+d0*32+r32]=__float2bfloat16(o[d0][r]*rli[r]);}
    asm volatile("s_waitcnt lgkmcnt(0)":::"memory");
    typedef unsigned u32x2 __attribute__((ext_vector_type(2)));
    #pragma unroll
    for(int i=0;i<4;++i){const int row=i*8+(lane>>3),ch=lane&7; const u32x4 v=*(const u32x4*)(stg+row*64+ch*8); float f[8];
      #pragma unroll
      for(int k=0;k<4;++k){f[2*k]=__builtin_amdgcn_fmed3f(__uint_as_float(v[k]<<16)*64.f,-448.f,448.f); f[2*k+1]=__builtin_amdgcn_fmed3f(__uint_as_float(v[k]&0xffff0000u)*64.f,-448.f,448.f);}
      u32x2 w8; w8.x=(unsigned)__builtin_amdgcn_cvt_pk_fp8_f32(f[2],f[3],__builtin_amdgcn_cvt_pk_fp8_f32(f[0],f[1],0,false),true); w8.y=(unsigned)__builtin_amdgcn_cvt_pk_fp8_f32(f[6],f[7],__builtin_amdgcn_cvt_pk_fp8_f32(f[4],f[5],0,false),true);
      *(u32x2*)(Ow+(long)row*OP+ch*8)=w8;} }
  asm volatile("s_waitcnt lgkmcnt(0)\n\ts_barrier":::"memory");
  #undef DMA_K
  #undef DMA_V
  #undef CMASK
  #undef START
  #undef RESC
  #undef ROT
}
constexpr int ATTN_LDS_BYTES=LDS_BYTES;
struct AttnTensors { const bf16* Q; const bf16* K; const bf16* V; bf16* O; };
struct AttnUnit { int bh; int qb; };
struct StaticOrder {
  int vcu;
  int G;
  __device__ __forceinline__ explicit StaticOrder(int v,int g):vcu(v),G(g){}
  __device__ __forceinline__ bool next(int i,AttnUnit&u)const{ const int vv=vcu+(i>>4)*G; if(vv>=256)return false; i&=15; const int pair=(vv>>3)+32*(i>>2); const int b=pair>>2,kvh=pair&3; u.bh=b*NHEAD+kvh*4+(vv&3); u.qb=(i&3)+4*((vv>>2)&1); return true; }
  __device__ __forceinline__ void a_ready(const AttnUnit&)const{}
  __device__ __forceinline__ void done(const AttnUnit&)const{}
};
template<class Sched,int THRL=8> __device__ __forceinline__ void attn_phase(char*lds,const AttnTensors&T,const Sched&S,const int wv){
  AttnUnit u;
  for(int i=0;S.next(i,u);++i){ S.a_ready(u); attn_unit<THRL>(u.bh/NHEAD,u.bh%NHEAD,u.qb,T.Q,T.K,T.V,T.O,lds,wv); S.done(u); }
}
#undef SBAR
#undef WAIT_BAR
}

constexpr size_t WS_WIN_T = 1072 * MiB;
constexpr size_t WS_WCAT_T = 1060 * MiB;
constexpr size_t WS_WOUT_T = 1064 * MiB;
constexpr size_t WS_WRS_T = 1066 * MiB + 512 * 1024;
constexpr size_t WS_WSD_T = 1068 * MiB;
constexpr size_t WS_WGU = 144 * MiB;
constexpr size_t WS_WD = 272 * MiB;
constexpr float SC_GR = 8.f, SC_GB = 256.f;
constexpr float SC_ATT = 64.f, SC_WMIX = 256.f, SC_GATED = 32.f;
constexpr float SC_H1 = 16.f, SC_WIN = 256.f;
constexpr float SC_H2 = 16.f, SC_WGU = 256.f, SC_WD = 8.f, SC_ACT = 4.f;
constexpr size_t WS_ACTS = 528 * MiB;
constexpr size_t WS_YT = 560 * MiB;
constexpr float YT_SCALE = 32.f;
constexpr size_t WS_BLKE = 3 * MiB + 64 * 1024;
constexpr int BLK_PER_CH = CH_SLOTS / 256;
constexpr size_t WS_BAR = 64 * 1024;
constexpr int RING_BYTES = 131072, LDSCTL_OFF = RING_BYTES, MISC_OFF = LDSCTL_OFF + 320, LDS_BYTES = 147456;
constexpr int NWAVES = 8;
constexpr int MOE_LDS_OFF = LDSCTL_OFF + 1024;

#define GAS __attribute__((address_space(1)))
#define LAS __attribute__((address_space(3)))
typedef unsigned v4u __attribute__((ext_vector_type(4)));
typedef unsigned v2u __attribute__((ext_vector_type(2)));
typedef float f32x4 __attribute__((ext_vector_type(4)));
#define LDS_WAIT() asm volatile("s_waitcnt lgkmcnt(0)" ::: "memory")
#define VM_WAIT() asm volatile("s_waitcnt vmcnt(0)" ::: "memory")
__device__ __forceinline__ unsigned pk2(float lo, float hi) { return (unsigned)f2bf(lo) | ((unsigned)f2bf(hi) << 16); }

#define XB_TMO      128
#define XB_XCNT(j)  (256  + 64 * (j))
#define XB_XSUB(j)  (1280 + 64 * (j))
#define XB_XGEN(j)  (2304 + 64 * (j))
#define XB_TOP      3328
#define XB_TOPGEN   3392
#define XCD_BAR_WORDS 3456
#define XB_SPIN_CAP (1u << 18)
__device__ __forceinline__ unsigned xb_ld(unsigned* p)              { return __hip_atomic_load(p, __ATOMIC_RELAXED, __HIP_MEMORY_SCOPE_AGENT); }
__device__ __forceinline__ unsigned xb_add(unsigned* p, unsigned v) { return __hip_atomic_fetch_add(p, v, __ATOMIC_RELAXED, __HIP_MEMORY_SCOPE_AGENT); }
__device__ __forceinline__ unsigned xb_xcc_id() { return (unsigned)__builtin_amdgcn_s_getreg((3 << 11) | 20) & 0xFu; }
#define XB_SPIN(cond, bar) do { unsigned _sp = 0; while (cond) { __builtin_amdgcn_s_sleep(1); \
    if ((++_sp & 255u) == 0u) { if (xb_ld(&(bar)[XB_TMO])) break; if (_sp > XB_SPIN_CAP) { atomicAdd(&(bar)[XB_TMO], 1u); break; } } } } while (0)
struct XcdBarrier { unsigned* bar; unsigned x; volatile LAS unsigned* st; int wv; };
__device__ __forceinline__ XcdBarrier xcd_barrier_post(unsigned* bar, volatile LAS unsigned* st, int wv) {
    XcdBarrier b; b.bar = bar; b.x = xb_xcc_id(); b.st = st; b.wv = wv;
    if (threadIdx.x == 0) (void)xb_add(&bar[XB_XCNT(b.x)], 1u);
    return b;
}
__device__ __forceinline__ void xcd_barrier_complete(unsigned* bar, unsigned x, unsigned& nloc, unsigned& nx) {
    const unsigned G = gridDim.x * gridDim.y * gridDim.z;
    unsigned sum, cnt, mine, sp = 0u;
    for (;;) {
        sum = 0u; cnt = 0u; mine = 0u;
#pragma unroll
        for (unsigned j = 0; j < 16; ++j) { const unsigned c = xb_ld(&bar[XB_XCNT(j)]); sum += c; cnt += (c > 0u) ? 1u : 0u; mine = (j == x) ? c : mine; }
        if (sum == G) break;
        __builtin_amdgcn_s_sleep(1);
        if ((++sp & 255u) == 0u) { if (xb_ld(&bar[XB_TMO])) break; if (sp > XB_SPIN_CAP) { atomicAdd(&bar[XB_TMO], 1u); break; } }
    }
    nloc = mine > 0u ? mine : 1u; nx = cnt > 0u ? cnt : 1u;
}
__device__ __forceinline__ void xcd_barrier(const XcdBarrier& b) {
    asm volatile("s_waitcnt vmcnt(0)" ::: "memory");
    __syncthreads();
    if (hw_tid(b.wv) == 0) {
        unsigned* bar = b.bar;
        __builtin_amdgcn_s_waitcnt(0);
        unsigned nloc = b.st[0], nx = b.st[1];
        if (nloc == 0u) { xcd_barrier_complete(bar, b.x, nloc, nx); b.st[0] = nloc; b.st[1] = nx; }
        const unsigned old = xb_add(&bar[XB_XSUB(b.x)], 1u);
        const unsigned gen = old / nloc;
        if (old + 1u == (gen + 1u) * nloc) {
            __builtin_amdgcn_fence(__ATOMIC_RELEASE, "agent");
            asm volatile("s_waitcnt vmcnt(0)" ::: "memory");
            const unsigned og = xb_add(&bar[XB_TOP], 1u);
            const unsigned tg = og / nx;
            if (og + 1u == (tg + 1u) * nx) xb_add(&bar[XB_TOPGEN], 1u);
            else XB_SPIN(xb_ld(&bar[XB_TOPGEN]) == tg, bar);
            __builtin_amdgcn_fence(__ATOMIC_ACQUIRE, "agent");
            xb_add(&bar[XB_XGEN(b.x)], 1u);
            asm volatile("s_waitcnt vmcnt(0)" ::: "memory");
        } else {
            XB_SPIN(xb_ld(&bar[XB_XGEN(b.x)]) == gen, bar);
            __builtin_amdgcn_fence(__ATOMIC_ACQUIRE, "agent");
            asm volatile("s_waitcnt vmcnt(0)" ::: "memory");
        }
    }
    __syncthreads();
}

struct Args { const float* in[22]; float* out; unsigned char* ws; int ph_lo, ph_hi, li, pad; };
enum Phase { PH_PRO = 0, PH_NORM1 = 1, PH_PROJ = 2, PH_ATT = 3, PH_MIX1 = 4, PH_MIX2 = 5, PH_NORM2 = 6, PH_RS = 7, PH_SCAT = 8, PH_EXP0 = 9, PH_COMB0 = 10, PH_END = 11 };

struct Frame {
    LAS unsigned char* lds; volatile LAS unsigned* MISC; unsigned char* ws;
    int tid, lane, wave, vcu, G;
};

template <class RowMap>
__device__ __forceinline__ void p0_transpose_item(const float* W, int K, int N, bf16* WT, int ldt, const RowMap& rm, LAS float* scr, int item, int lane) {
    const int nblk = N / 32, kb = item / nblk, nb = item % nblk, k0 = 64 * kb, n0 = 32 * nb;
#pragma unroll 8
    for (int i = 0; i < 32; ++i) { const int kk = 2 * i + (lane >> 5); scr[kk * 33 + (lane & 31)] = W[(size_t)(k0 + kk) * N + n0 + (lane & 31)]; }
    LDS_WAIT(); asm volatile("" ::: "memory");
    const int c = lane & 7;
#pragma unroll
    for (int j = 0; j < 4; ++j) { const int n = (lane >> 3) + 8 * j; const LAS float* s = scr + (8 * c) * 33 + n;
        v4u o; o.x = pk2(s[0 * 33], s[1 * 33]); o.y = pk2(s[2 * 33], s[3 * 33]); o.z = pk2(s[4 * 33], s[5 * 33]); o.w = pk2(s[6 * 33], s[7 * 33]);
        *(GAS v4u*)(WT + (size_t)rm(n0 + n) * ldt + k0 + 8 * c) = o; }
    LDS_WAIT(); asm volatile("" ::: "memory");
}
__device__ __forceinline__ unsigned pk4_fp8(float a, float b, float c, float d) {
    a = __builtin_amdgcn_fmed3f(a, -448.f, 448.f); b = __builtin_amdgcn_fmed3f(b, -448.f, 448.f); c = __builtin_amdgcn_fmed3f(c, -448.f, 448.f); d = __builtin_amdgcn_fmed3f(d, -448.f, 448.f);
    return (unsigned)__builtin_amdgcn_cvt_pk_fp8_f32(c, d, __builtin_amdgcn_cvt_pk_fp8_f32(a, b, 0, false), true);
}
template <class RowMap>
__device__ __forceinline__ void p0_transpose_item8(const float* W, int K, int N, unsigned char* WT, int ldt, const RowMap& rm, LAS float* scr, int item, int lane, float scale) {
    const int nblk = N / 32, kb = item / nblk, nb = item % nblk, k0 = 64 * kb, n0 = 32 * nb;
#pragma unroll 8
    for (int i = 0; i < 32; ++i) { const int kk = 2 * i + (lane >> 5); scr[kk * 33 + (lane & 31)] = W[(size_t)(k0 + kk) * N + n0 + (lane & 31)] * scale; }
    LDS_WAIT(); asm volatile("" ::: "memory");
    const int c = lane & 3;
#pragma unroll
    for (int j = 0; j < 2; ++j) { const int n = (lane >> 2) + 16 * j; const LAS float* s_ = scr + (16 * c) * 33 + n;
        v4u o; o.x = pk4_fp8(s_[0 * 33], s_[1 * 33], s_[2 * 33], s_[3 * 33]); o.y = pk4_fp8(s_[4 * 33], s_[5 * 33], s_[6 * 33], s_[7 * 33]);
        o.z = pk4_fp8(s_[8 * 33], s_[9 * 33], s_[10 * 33], s_[11 * 33]); o.w = pk4_fp8(s_[12 * 33], s_[13 * 33], s_[14 * 33], s_[15 * 33]);
        *(GAS v4u*)(WT + (size_t)rm(n0 + n) * ldt + k0 + 16 * c) = o; }
    LDS_WAIT(); asm volatile("" ::: "memory");
}
__host__ __device__ __forceinline__ int win_dst_row(int o) {
    if (o >= C_GT) { const int c = o - C_GT, which = c >> 10, col = c & 1023; return C_GT + (col >> 7) * 256 + which * 128 + (col & 127); }
    const bool permuted = (o < C_VA) || (o >= C_QB && o < C_VB);
    if (!permuted) return o;
    const int tile = o & ~255, w = o & 255, wc = w >> 6, dim = w & 63;
    if (o < C_VA) return tile + 128 * (dim >> 5) + 32 * wc + (dim & 31);
    const int half = dim >> 5, dd = dim & 31, bj = (dd >> 4) & 1, u = (dd >> 3) & 1;
    return tile + 128 * bj + 32 * wc + 8 * (2 * half + u) + (dd & 7);
}
struct RmWin { __device__ __forceinline__ int operator()(int n) const { return win_dst_row(n); } };
struct RmSh { int off; __device__ __forceinline__ int operator()(int ff) const { return off + (ff >> 7) * 256 + (ff & 127); } };
struct RmId { int off; __device__ __forceinline__ int operator()(int n) const { return n + off; } };

struct EpiP1 {
    static constexpr bool PERM = true; static constexpr int HOOK_T = -1; static constexpr bool F8 = true;
    static constexpr float DQ = 1.f / (SC_H1 * SC_WIN);
    unsigned char* ws; const float* rope; const float* qn_g; const float* kn_g; const float* b_gate;
    __device__ __forceinline__ void operator()(const pg8::f32x4 (&acc)[2][2][4][2], const pg8::Unit& u, int wr, int wc, int fr, int fq) const {
        using pg8::cvt_pk_bf16; typedef pg8::f32x4 f4;
        const int pn = u.pn; int fr_ = fr, fq_ = fq; asm volatile("" : "+v"(fr_), "+v"(fq_)); const int row0 = u.pm * 256 + wr * 64 + fr_;
        if (pn < 6) {
            const bool isq = pn < 3; bf16* O = (bf16*)(ws + (isq ? WS_QA : WS_KA)); const int hc = (isq ? pn : pn - 3) * 256 + wc * 64 + 8 * fq_; const float sc = (isq ? QSCALE : 1.f) * DQ;
            const float* C1 = rope; const float* S1 = rope + 65536;
#pragma unroll
            for (int ai = 0; ai < 2; ++ai)
#pragma unroll
                for (int m = 0; m < 4; ++m) { const int row = row0 + ai * 128 + m * 16; const int t = row & (SEQ - 1);
                    bf16* op = O + (size_t)row * DILW + hc; pg8::u32x4 w1, w2;
#pragma unroll
                    for (int n = 0; n < 2; ++n) { const f4 c = *(const f4*)(C1 + t * 32 + 8 * fq_ + 4 * n), s = *(const f4*)(S1 + t * 32 + 8 * fq_ + 4 * n);
                        const f4 x1 = acc[ai][0][m][n], x2 = acc[ai][1][m][n]; const f4 o1 = (x1 * c - x2 * s) * sc, o2 = (x2 * c + x1 * s) * sc;
                        w1[2 * n] = cvt_pk_bf16(o1[0], o1[1]); w1[2 * n + 1] = cvt_pk_bf16(o1[2], o1[3]); w2[2 * n] = cvt_pk_bf16(o2[0], o2[1]); w2[2 * n + 1] = cvt_pk_bf16(o2[2], o2[3]); }
                    *(pg8::u32x4*)op = w1; *(pg8::u32x4*)(op + 32) = w2; }
        } else if (pn >= 9 && pn < 14) {
            const bool isq = pn < 13; bf16* O = (bf16*)(ws + (isq ? WS_QB : WS_KB)); const int ld = isq ? GQW : GKW; const int half = fq_ >> 1, u8 = 8 * (fq_ & 1);
            const int hc = (isq ? (pn - 9) * 256 : 0) + wc * 64 + 32 * half + u8;
            const float* g = isq ? qn_g : kn_g; const float sc = isq ? QSCALE : 1.f;
            const float* CR = rope + 131072; const float* SR = CR + 512; const float* CC = SR + 512; const float* SC = CC + 1024;
            f4 gv[2][2]; const int lane_ = (fq_ << 4) | fr_;
#pragma unroll
            for (int bj = 0; bj < 2; ++bj)
#pragma unroll
                for (int n = 0; n < 2; ++n) gv[bj][n] = *(const f4*)(g + 32 * half + u8 + 16 * bj + 4 * n);
#pragma unroll
            for (int ai = 0; ai < 2; ++ai)
#pragma unroll
                for (int m = 0; m < 4; ++m) { const int row = row0 + ai * 128 + m * 16; const int t = row & (SEQ - 1), rp = t >> 6, cp = t & 63;
                    float ss = 0.f;
#pragma unroll
                    for (int bj = 0; bj < 2; ++bj)
#pragma unroll
                        for (int n = 0; n < 2; ++n) { const f4 v = acc[ai][bj][m][n]; ss += (v[0] * v[0] + v[1] * v[1]) + (v[2] * v[2] + v[3] * v[3]); }
                    ss += __builtin_bit_cast(float, __builtin_amdgcn_ds_bpermute(((lane_ ^ 16) << 2), __builtin_bit_cast(int, ss))); ss += __builtin_bit_cast(float, __builtin_amdgcn_ds_bpermute(((lane_ ^ 32) << 2), __builtin_bit_cast(int, ss)));
                    const float rstd = (1.f / sqrtf(ss * (DQ * DQ / 64.f) + NORM_EPS)) * (sc * DQ);
                    bf16* op = O + (size_t)row * ld + hc; pg8::u32x4 w1, w2;
                    const float* ct = half ? (CC + cp * 16 + u8) : (CR + rp * 16 + u8); const float* st = half ? (SC + cp * 16 + u8) : (SR + rp * 16 + u8);
#pragma unroll
                    for (int n = 0; n < 2; ++n) { const f4 c = *(const f4*)(ct + 4 * n), s = *(const f4*)(st + 4 * n);
                        const f4 y1 = acc[ai][0][m][n] * rstd * gv[0][n], y2 = acc[ai][1][m][n] * rstd * gv[1][n]; const f4 o1 = y1 * c - y2 * s, o2 = y2 * c + y1 * s;
                        w1[2 * n] = cvt_pk_bf16(o1[0], o1[1]); w1[2 * n + 1] = cvt_pk_bf16(o1[2], o1[3]); w2[2 * n] = cvt_pk_bf16(o2[0], o2[1]); w2[2 * n + 1] = cvt_pk_bf16(o2[2], o2[3]); }
                    *(pg8::u32x4*)op = w1; *(pg8::u32x4*)(op + 16) = w2; }
        } else if (pn >= 15) {
            bf16* O = (bf16*)(ws + WS_GATES); const int col0 = (pn - 15) * 128 + wc * 32 + 8 * fq_;
            f4 ba[2], bb[2];
#pragma unroll
            for (int n = 0; n < 2; ++n) { ba[n] = *(const f4*)(b_gate + col0 + 4 * n) * -1.44269504f; bb[n] = *(const f4*)(b_gate + 1024 + col0 + 4 * n) * -1.44269504f; }
#pragma unroll
            for (int ai = 0; ai < 2; ++ai)
#pragma unroll
                for (int m = 0; m < 4; ++m) { char* rowp = (char*)O + (size_t)(row0 + ai * 128 + m * 16) * 2048 + col0 * 2; float r[8], g[8];
#pragma unroll
                    for (int n = 0; n < 2; ++n)
#pragma unroll
                        for (int j = 0; j < 4; ++j) { const float ea = 1.f + __builtin_amdgcn_exp2f(__builtin_fmaf(acc[ai][0][m][n][j], -DQ * 1.44269504f, ba[n][j])), eb = 1.f + __builtin_amdgcn_exp2f(__builtin_fmaf(acc[ai][1][m][n][j], -DQ * 1.44269504f, bb[n][j]));
                            g[4 * n + j] = __builtin_amdgcn_rcpf(eb); r[4 * n + j] = eb * __builtin_amdgcn_rcpf(ea); }
                    pg8::u32x4 w_; w_.x = pk4_fp8(r[0] * SC_GR, r[1] * SC_GR, r[2] * SC_GR, r[3] * SC_GR); w_.y = pk4_fp8(r[4] * SC_GR, r[5] * SC_GR, r[6] * SC_GR, r[7] * SC_GR);
                    w_.z = pk4_fp8(g[0] * SC_GB, g[1] * SC_GB, g[2] * SC_GB, g[3] * SC_GB); w_.w = pk4_fp8(g[4] * SC_GB, g[5] * SC_GB, g[6] * SC_GB, g[7] * SC_GB);
                    *(pg8::u32x4*)rowp = w_; }
        } else {
            bf16* O; int ld, cb;
            if (pn < 9) { O = (bf16*)(ws + WS_VA); ld = DILW; cb = (pn - 6) * 256; }
            else { O = (bf16*)(ws + WS_VB); ld = GKW; cb = 0; }
            const int col0 = cb + wc * 32 + 8 * fq_;
#pragma unroll
            for (int ai = 0; ai < 2; ++ai)
#pragma unroll
                for (int m = 0; m < 4; ++m) { bf16* rowp = O + (size_t)(row0 + ai * 128 + m * 16) * ld + col0;
#pragma unroll
                    for (int bj = 0; bj < 2; ++bj) { const f4 v0 = acc[ai][bj][m][0] * DQ, v1 = acc[ai][bj][m][1] * DQ;
                        pg8::u32x4 w; w.x = cvt_pk_bf16(v0[0], v0[1]); w.y = cvt_pk_bf16(v0[2], v0[3]); w.z = cvt_pk_bf16(v1[0], v1[1]); w.w = cvt_pk_bf16(v1[2], v1[3]);
                        *(pg8::u32x4*)(rowp + bj * 128) = w; } }
        }
    }
};

struct EpiGatedF {
    static constexpr bool PERM = true; static constexpr int HOOK_T = 2; static constexpr bool F8 = true;
    const bf16* gates; unsigned char* gated;
    __device__ __forceinline__ void hook(pg8::f32x4 (&acc)[2][2][4][2], const pg8::Unit& u, int wr, int wc, int fr, int fq) const {
        int fr_ = fr, fq_ = fq; asm volatile("" : "+v"(fr_), "+v"(fq_)); const int row0 = u.pm * 256 + wr * 64 + fr_; const int col0 = u.pn * 256 + wc * 32 + 8 * fq_;
        typedef float f2_ __attribute__((ext_vector_type(2)));
        const char* gbase = (const char*)gates; const unsigned goff0 = (unsigned)row0 * 2048u + (unsigned)col0 * 2u;
#pragma unroll
        for (int ai = 0; ai < 2; ++ai) {
#pragma unroll
            for (int m = 0; m < 4; ++m) { const char* gp = gbase + (goff0 + (unsigned)(ai * 128 + m * 16) * 2048u);
#pragma unroll
                for (int bj = 0; bj < 2; ++bj) { const pg8::u32x2 ga = *(const pg8::u32x2*)(gp + bj * 256);
#pragma unroll
                    for (int n = 0; n < 2; ++n) { const f2_ lo = __builtin_amdgcn_cvt_pk_f32_fp8((int)ga[n], false), hi = __builtin_amdgcn_cvt_pk_f32_fp8((int)ga[n], true);
                        acc[ai][bj][m][n][0] *= lo[0] * (1.f / SC_GR); acc[ai][bj][m][n][1] *= lo[1] * (1.f / SC_GR); acc[ai][bj][m][n][2] *= hi[0] * (1.f / SC_GR); acc[ai][bj][m][n][3] *= hi[1] * (1.f / SC_GR); } }
                if (m & 1) asm volatile("" ::: "memory"); }
        }
    }
    __device__ __forceinline__ void operator()(const pg8::f32x4 (&acc)[2][2][4][2], const pg8::Unit& u, int wr, int wc, int fr, int fq) const {
        using pg8::cvt_pk_bf16;
        int fr_ = fr, fq_ = fq; asm volatile("" : "+v"(fr_), "+v"(fq_)); const int row0 = u.pm * 256 + wr * 64 + fr_; const int col0 = u.pn * 256 + wc * 32 + 8 * fq_;
        typedef float f2_ __attribute__((ext_vector_type(2)));
        const char* gbase = (const char*)gates; const unsigned goff0 = (unsigned)row0 * 2048u + (unsigned)col0 * 2u + 8u;
        char* obase = (char*)gated; const unsigned ooff0 = (unsigned)row0 * (unsigned)DM + (unsigned)col0;
        constexpr float OS = SC_GATED / (SC_ATT * SC_WMIX);
#pragma unroll
        for (int ai = 0; ai < 2; ++ai) {
#pragma unroll
            for (int m = 0; m < 4; ++m) {
#pragma unroll
                for (int bj = 0; bj < 2; ++bj) { const pg8::u32x2 gb = *(const pg8::u32x2*)(gbase + (goff0 + (unsigned)(ai * 128 + m * 16) * 2048u + (unsigned)bj * 256u));
                    float v[8];
#pragma unroll
                    for (int n = 0; n < 2; ++n) { const f2_ lo = __builtin_amdgcn_cvt_pk_f32_fp8((int)gb[n], false), hi = __builtin_amdgcn_cvt_pk_f32_fp8((int)gb[n], true);
                        v[4 * n] = acc[ai][bj][m][n][0] * ((OS / SC_GB) * lo[0]); v[4 * n + 1] = acc[ai][bj][m][n][1] * ((OS / SC_GB) * lo[1]); v[4 * n + 2] = acc[ai][bj][m][n][2] * ((OS / SC_GB) * hi[0]); v[4 * n + 3] = acc[ai][bj][m][n][3] * ((OS / SC_GB) * hi[1]); }
                    pg8::u32x2 o; o.x = pk4_fp8(v[0], v[1], v[2], v[3]); o.y = pk4_fp8(v[4], v[5], v[6], v[7]);
                    *(pg8::u32x2*)(obase + (ooff0 + (unsigned)(ai * 128 + m * 16) * 1024u + (unsigned)bj * 128u)) = o; } }
            asm volatile("" ::: "memory");
        }
    }
};
struct EpiXmidF {
    static constexpr bool PERM = true; static constexpr int HOOK_T = -1; static constexpr bool F8 = true; static constexpr float DQ = 1.f / (SC_GATED * SC_WMIX);
    const float* x; const float* mod; bf16* xmid;
    __device__ __forceinline__ void operator()(const pg8::f32x4 (&acc)[2][2][4][2], const pg8::Unit& u, int wr, int wc, int fr, int fq) const {
        using pg8::cvt_pk_bf16; typedef pg8::f32x4 f4;
        int fr_ = fr, fq_ = fq; asm volatile("" : "+v"(fr_), "+v"(fq_)); const int row0 = u.pm * 256 + wr * 64 + fr_; const int col0 = u.pn * 256 + wc * 32 + 8 * fq_; const int b = (u.pm * 256) / SEQ;
        const char* xb = (const char*)x; char* ob = (char*)xmid; const unsigned off0 = (unsigned)row0 * (unsigned)DM + (unsigned)col0;
        f4 gv[2][2];
#pragma unroll
        for (int bj = 0; bj < 2; ++bj)
#pragma unroll
            for (int n = 0; n < 2; ++n) gv[bj][n] = *(const f4*)(mod + (size_t)b * 6144 + 2 * DM + col0 + bj * 128 + 4 * n) * DQ;
#pragma unroll
        for (int ai = 0; ai < 2; ++ai) {
#pragma unroll
            for (int m = 0; m < 4; ++m) { const unsigned off = off0 + (unsigned)(ai * 128 + m * 16) * (unsigned)DM;
#pragma unroll
                for (int bj = 0; bj < 2; ++bj) { const f4 x0 = *(const f4*)(xb + (size_t)(off + bj * 128) * 4), x1 = *(const f4*)(xb + (size_t)(off + bj * 128 + 4) * 4);
                    const f4 v0 = x0 + gv[bj][0] * acc[ai][bj][m][0], v1 = x1 + gv[bj][1] * acc[ai][bj][m][1];
                    pg8::u32x4 o; o.x = cvt_pk_bf16(v0[0], v0[1]); o.y = cvt_pk_bf16(v0[2], v0[3]); o.z = cvt_pk_bf16(v1[0], v1[1]); o.w = cvt_pk_bf16(v1[2], v1[3]);
                    *(pg8::u32x4*)(ob + (size_t)(off + bj * 128) * 2) = o; } }
            asm volatile("" ::: "memory");
        }
    }
};

struct PanelOrder {
    int nP, nN, G, c;
    __device__ void init(int M, int N, int G_, int c_) { nP = M / 256; nN = N / 256; G = G_; c = c_; }
    __device__ bool next(int i, pg8::Unit& u) const { const int p = c + (i / nN) * G; if (p >= nP) return false; u.pm = p; u.pn = i % nN; return true; }
    __device__ __forceinline__ void a_ready(const pg8::Unit&) const {}
    __device__ __forceinline__ void done(const pg8::Unit&) const {}
};
struct EpiRS {
    static constexpr bool PERM = true; static constexpr int HOOK_T = -1;
    float* logits; bf16* shact;
    __device__ __forceinline__ void operator()(const pg8::f32x4 (&acc)[2][2][4][2], const pg8::Unit& u, int wr, int wc, int fr, int fq) const {
        using pg8::cvt_pk_bf16; typedef pg8::f32x4 f4;
        int fr_ = fr, fq_ = fq; asm volatile("" : "+v"(fr_), "+v"(fq_)); const int row0 = u.pm * 256 + wr * 64 + fr_;
        if (u.pn == 0) {
            char* lb = (char*)logits; const unsigned off0 = ((unsigned)row0 * 256u + (unsigned)(wc * 32 + 8 * fq_)) * 4u;
#pragma unroll
            for (int ai = 0; ai < 2; ++ai)
#pragma unroll
                for (int m = 0; m < 4; ++m)
#pragma unroll
                    for (int bj = 0; bj < 2; ++bj)
#pragma unroll
                        for (int n = 0; n < 2; ++n) *(f4*)(lb + (off0 + (unsigned)(ai * 128 + m * 16) * 1024u + (unsigned)(bj * 128 + 4 * n) * 4u)) = acc[ai][bj][m][n];
        } else {
            char* sb = (char*)shact; const unsigned off0 = ((unsigned)row0 * 256u + (unsigned)((u.pn - 1) * 128 + wc * 32 + 8 * fq_)) * 2u;
#pragma unroll
            for (int ai = 0; ai < 2; ++ai)
#pragma unroll
                for (int m = 0; m < 4; ++m) { float v[8];
#pragma unroll
                    for (int n = 0; n < 2; ++n)
#pragma unroll
                        for (int i = 0; i < 4; ++i) { const float g = acc[ai][0][m][n][i], up = acc[ai][1][m][n][i]; v[4 * n + i] = g * __builtin_amdgcn_rcpf(1.f + __expf(-g)) * up; }
                    pg8::u32x4 o; o.x = cvt_pk_bf16(v[0], v[1]); o.y = cvt_pk_bf16(v[2], v[3]); o.z = cvt_pk_bf16(v[4], v[5]); o.w = cvt_pk_bf16(v[6], v[7]);
                    *(pg8::u32x4*)(sb + (off0 + (unsigned)(ai * 128 + m * 16) * 512u)) = o; }
        }
    }
};
struct EpiShDownF {
    static constexpr bool PERM = true; static constexpr int HOOK_T = -1;
    const float* mod; bf16* xo;
    __device__ __forceinline__ void operator()(const pg8::f32x4 (&acc)[2][2][4][2], const pg8::Unit& u, int wr, int wc, int fr, int fq) const {
        using pg8::cvt_pk_bf16; typedef pg8::f32x4 f4;
        int fr_ = fr, fq_ = fq; asm volatile("" : "+v"(fr_), "+v"(fq_)); const int row0 = u.pm * 256 + wr * 64 + fr_; const int col0 = u.pn * 256 + wc * 32 + 8 * fq_; const int b = (u.pm * 256) / SEQ;
        char* ob = (char*)xo; const unsigned off0 = ((unsigned)row0 * (unsigned)DM + (unsigned)col0) * 2u;
        f4 gv[2][2];
#pragma unroll
        for (int bj = 0; bj < 2; ++bj)
#pragma unroll
            for (int n = 0; n < 2; ++n) gv[bj][n] = *(const f4*)(mod + (size_t)b * 6144 + 5 * DM + col0 + bj * 128 + 4 * n);
#pragma unroll
        for (int ai = 0; ai < 2; ++ai) {
#pragma unroll
            for (int m = 0; m < 4; ++m) { const unsigned off = off0 + (unsigned)(ai * 128 + m * 16) * 2048u;
#pragma unroll
                for (int bj = 0; bj < 2; ++bj) { pg8::u32x4* p = (pg8::u32x4*)(ob + (off + (unsigned)bj * 256u)); const pg8::u32x4 w = *p;
                    const f4 v0 = gv[bj][0] * acc[ai][bj][m][0], v1 = gv[bj][1] * acc[ai][bj][m][1];
                    pg8::u32x4 o; o.x = cvt_pk_bf16(__uint_as_float(w.x << 16) + v0[0], __uint_as_float(w.x & 0xffff0000u) + v0[1]); o.y = cvt_pk_bf16(__uint_as_float(w.y << 16) + v0[2], __uint_as_float(w.y & 0xffff0000u) + v0[3]);
                    o.z = cvt_pk_bf16(__uint_as_float(w.z << 16) + v1[0], __uint_as_float(w.z & 0xffff0000u) + v1[1]); o.w = cvt_pk_bf16(__uint_as_float(w.w << 16) + v1[2], __uint_as_float(w.w & 0xffff0000u) + v1[3]);
                    *p = o; } }
            asm volatile("" ::: "memory");
        }
    }
};
__device__ __forceinline__ void topk_row(const float* logits, const float* rbias, int t, int lane, int* IDX, float* GATEV, int* POSE, int* counts) {
    const float4 lg = *(const float4*)(logits + (size_t)t * NEXP + 4 * lane); const float4 rb = *(const float4*)(rbias + 4 * lane);
    float s[4] = {sigmoidf_(lg.x), sigmoidf_(lg.y), sigmoidf_(lg.z), sigmoidf_(lg.w)};
    float v[4] = {s[0] + rb.x, s[1] + rb.y, s[2] + rb.z, s[3] + rb.w};
    float m1 = fmaxf(v[0], v[1]), m2 = fminf(v[0], v[1]);
    { const float a = fmaxf(v[2], v[3]), c = fminf(v[2], v[3]); const float n1 = fmaxf(m1, a); const float n2 = fmaxf(fminf(m1, a), fmaxf(m2, c)); m1 = n1; m2 = n2; }
#pragma unroll
    for (int o = 1; o < 8; o <<= 1) { const float a1 = __shfl_xor(m1, o), a2 = __shfl_xor(m2, o); const float n1 = fmaxf(m1, a1); const float n2 = fmaxf(fminf(m1, a1), fmaxf(m2, a2)); m1 = n1; m2 = n2; }
    const float gs = m1 + m2; const int grp = lane >> 3; int rank = 0;
#pragma unroll
    for (int g2 = 0; g2 < 8; ++g2) { const float o = __shfl(gs, 8 * g2); rank += (o > gs || (o == gs && g2 < grp)) ? 1 : 0; }
    const bool sel = rank < 4;
#pragma unroll
    for (int i = 0; i < 4; ++i) if (!sel) v[i] = -INFINITY;
    int myidx = 0; float mysc = 0.f; float ssum = 0.f;
    for (int k = 0; k < TOPK; ++k) {
        float bv = v[0]; int bi = 4 * lane;
#pragma unroll
        for (int i = 1; i < 4; ++i) if (v[i] > bv) { bv = v[i]; bi = 4 * lane + i; }
#pragma unroll
        for (int o = 1; o < 64; o <<= 1) { const float ov = __shfl_xor(bv, o); const int oi = __shfl_xor(bi, o); if (ov > bv || (ov == bv && oi < bi)) { bv = ov; bi = oi; } }
        const int wl = bi >> 2, wi = bi & 3;
        float sc = 0.f;
        if (lane == wl) {
#pragma unroll
            for (int i = 0; i < 4; ++i) if (i == wi) { sc = s[i]; v[i] = -INFINITY; }
        }
        sc = __shfl(sc, wl); ssum += sc;
        if (lane == k) { myidx = bi; mysc = sc; }
    }
    if (lane < TOPK) {
        const int chunk = t / CH_TOK;
        IDX[(size_t)t * TOPK + lane] = myidx; GATEV[(size_t)t * TOPK + lane] = mysc / ssum * 2.5f;
        POSE[(size_t)t * TOPK + lane] = atomicAdd(&counts[chunk * NEXP + myidx], 1);
    }
}


struct MUnit { const char* A; const char* B; int nt, lda2, ldb2, kind, sub, slot0, restart, gather, mu; };
__device__ __forceinline__ int ld_agent(const int* p) { return __hip_atomic_load(p, __ATOMIC_RELAXED, __HIP_MEMORY_SCOPE_AGENT); }
constexpr int MOE_MAXMU = 16;
struct MoeOrder {
    int c, G, w; const LAS int* blk; const char* H2; const char* WGU; const char* WD; const char* acts;
    __device__ __forceinline__ bool next(int i, MUnit& u) const {
        const int mu = i / 6, j = i - mu * 6; const int g = w + mu * G; if (g >= BLK_PER_CH || mu >= MOE_MAXMU) return false;
        const int e = __builtin_amdgcn_readfirstlane(blk[mu]); if (e < 0) return false;
        u.slot0 = c * CH_SLOTS + 256 * g; u.mu = mu;
        if (j < 2) { u.kind = 0; u.sub = j; u.A = H2; u.B = WGU + ((size_t)e * 512 + (size_t)j * 256) * 1024; u.nt = 8; u.lda2 = 1024; u.ldb2 = 1024; u.gather = 1; u.restart = 0; }
        else { u.kind = 1; u.sub = j - 2; u.A = acts; u.B = WD + ((size_t)e * 1024 + (size_t)(j - 2) * 256) * 256; u.nt = 2; u.lda2 = 256; u.ldb2 = 256; u.gather = 0; u.restart = (j == 2) ? 1 : 0; }
        return true;
    }
};
template <class E1, class E2>
__device__ __forceinline__ void gemm_phase_moe(PG8_LAS unsigned char* lds, const MoeOrder& S, const E1& e1, const E2& e2, const int* stok, const float* sgate, PG8_LAS int* tcode, PG8_LAS float* tgate, const int wv) {
    using namespace pg8;
    int tid = hw_tid(wv);
    const int wid = __builtin_amdgcn_readfirstlane(tid >> 6), lane = tid & 63, wr = wid >> 2, wc = wid & 3, fr = lane & 15, fq = lane >> 4;
    const size_t kstep = (size_t)(BK * 2);
    const unsigned ldsw = (unsigned)wid * 1024u;
    const int aoff = lds_byte(wr * 64 + fr, fq * 8), boff = lds_byte(wc * 32 + fr, fq * 8);
#define PG8_SA(b, h) (((b) * 2 + (h)) * HTB)
#define PG8_SB(b, h) ((4 + (b) * 2 + (h)) * HTB)
#define PG8_STAGE(bufoff, gbase, voff) do { _Pragma("unroll") for (int _i = 0; _i < 2; ++_i) { unsigned o_ = (voff)[_i]; asm volatile("" : "+v"(o_));   \
        __builtin_amdgcn_global_load_lds((const unsigned*)((const char*)(gbase) + o_), (PG8_LAS unsigned*)(lds + (bufoff) + ldsw + _i * 8192), 16, 0, 0); } } while (0)
#define PG8_LDA(dst, b, h) do { _Pragma("unroll") for (int m = 0; m < 4; ++m) _Pragma("unroll") for (int k = 0; k < 2; ++k) dst[m][k] = *(const PG8_LAS bf16x8*)(lds + PG8_SA(b, h) + aoff + m * 2048 + k * 1024); } while (0)
#define PG8_LDB(dst, b, h) do { _Pragma("unroll") for (int n = 0; n < 2; ++n) _Pragma("unroll") for (int k = 0; k < 2; ++k) dst[n][k] = *(const PG8_LAS bf16x8*)(lds + PG8_SB(b, h) + boff + n * 2048 + k * 1024); } while (0)
    typedef int i32x8_t __attribute__((ext_vector_type(8))); typedef int i32x4_t __attribute__((ext_vector_type(4)));
#define PG8_CAT(lo, hi) __builtin_shufflevector(__builtin_bit_cast(i32x4_t, lo), __builtin_bit_cast(i32x4_t, hi), 0, 1, 2, 3, 4, 5, 6, 7)
#define PG8_MMA(ai, bj, At, Bt) do { __builtin_amdgcn_s_setprio(1); _Pragma("unroll") for (int m = 0; m < 4; ++m) _Pragma("unroll") for (int n = 0; n < 2; ++n) \
        acc[ai][bj][m][n] = __builtin_amdgcn_mfma_scale_f32_16x16x128_f8f6f4(PG8_CAT(Bt[n][0], Bt[n][1]), PG8_CAT(At[m][0], At[m][1]), acc[ai][bj][m][n], 0, 0, 0, 0x7F7F7F7F, 0, 0x7F7F7F7F); \
        __builtin_amdgcn_s_setprio(0); } while (0)
#define PG8_WAIT_V(n) asm volatile("s_waitcnt vmcnt(" #n ")" ::: "memory")
#define PG8_WAIT_VF(f) asm volatile("s_cmp_lg_u32 %0, 0\n\ts_cbranch_scc1 1f\n\ts_waitcnt vmcnt(8)\n1:\n\ts_waitcnt vmcnt(16)" :: "s"((int)(f)) : "memory", "scc")
#define PG8_STAGE_UNLESS(f, bufoff, gbase, voff) do { unsigned keep_; \
        asm volatile("s_cmp_lg_u32 %5, 0\n\ts_cbranch_scc1 1f\n\ts_mov_b32 %0, m0\n\ts_mov_b32 m0, %3\n\ts_nop 0\n\tglobal_load_lds_dwordx4 %1, %6\n\ts_mov_b32 m0, %4\n\ts_nop 0\n\tglobal_load_lds_dwordx4 %2, %6\n\ts_mov_b32 m0, %0\n1:" \
                     : "=&s"(keep_) : "v"((voff)[0]), "v"((voff)[1]), "s"((unsigned)(size_t)(lds + (bufoff) + ldsw)), "s"((unsigned)(size_t)(lds + (bufoff) + ldsw + 8192)), "s"((int)(f)), "s"(gbase) : "memory", "scc"); } while (0)
#define PG8_WAIT_L(n) asm volatile("s_waitcnt lgkmcnt(" #n ")" ::: "memory")
#define PG8_BAR __builtin_amdgcn_s_barrier()
#define PG8_SCHED __builtin_amdgcn_sched_barrier(0)
#define MOE_GEOM() int gR[2], gC2[2], gRb[2]; { int t_ = tid; asm volatile("" : "+v"(t_)); _Pragma("unroll") for (int _i = 0; _i < 2; ++_i) { int R_, C_; stage_rc(t_ * 16 + _i * 8192, R_, C_); gR[_i] = R_; gC2[_i] = C_ * 2; gRb[_i] = (R_ & ~31) + perm32(R_ & 31); } }
#define MOE_OFFS(vA_, vB_, hB_, u, use_tok, keepA) do { MOE_GEOM(); \
        if (!(keepA)) { if (use_tok) { _Pragma("unroll") for (int _h = 0; _h < 2; ++_h) _Pragma("unroll") for (int _i = 0; _i < 2; ++_i) { const int _t = tcode[((u).mu & 1) * 256 + _h * 128 + gR[_i]] >> 3; vA_[_h][_i] = (unsigned)(_t < 0 ? 0 : _t) * 1024u + (unsigned)gC2[_i]; } } \
                        else { _Pragma("unroll") for (int _h = 0; _h < 2; ++_h) _Pragma("unroll") for (int _i = 0; _i < 2; ++_i) vA_[_h][_i] = (unsigned)((gR[_i] + 128 * _h) * (u).lda2 + gC2[_i]); } } \
          \
        if ((u).kind == 1) { _Pragma("unroll") for (int _i = 0; _i < 2; ++_i) { const int l_ = gRb[_i] & 31; vB_[_i] = (unsigned)((2 * (gRb[_i] & ~31) + ((l_ & 24) << 1) + (l_ & 7)) * (u).ldb2 + gC2[_i]); } hB_ = (size_t)8 * (size_t)(u).ldb2; } \
        else { _Pragma("unroll") for (int _i = 0; _i < 2; ++_i) vB_[_i] = (unsigned)(gRb[_i] * (u).ldb2 + gC2[_i]); hB_ = (size_t)128 * (size_t)(u).ldb2; } } while (0)
    MUnit cur, nxt; int ui = 0;
    if (!S.next(0, cur)) return;
    if (tid < 256) { tcode[tid] = stok[cur.slot0 + tid]; tgate[tid] = sgate[cur.slot0 + tid]; }
    asm volatile("s_waitcnt vmcnt(0) lgkmcnt(0)" ::: "memory"); __builtin_amdgcn_s_barrier(); asm volatile("" ::: "memory");
    f32x4 acc[2][2][4][2];
#pragma unroll
    for (int a = 0; a < 2; ++a)
#pragma unroll
        for (int b = 0; b < 2; ++b)
#pragma unroll
            for (int m = 0; m < 4; ++m)
#pragma unroll
                for (int n = 0; n < 2; ++n) acc[a][b][m][n] = (f32x4){0.f, 0.f, 0.f, 0.f};
    bf16x8 At[4][2], B0[2][2], B1[2][2];
    unsigned vA[2][2], vB[2]; size_t hB;
    MOE_OFFS(vA, vB, hB, cur, cur.gather, false);
    bool fresh = true, post = false;
    for (;;) {
        const char* cA = cur.A; const char* cB = cur.B;
        if (fresh) {
            PG8_STAGE(PG8_SB(0, 0), cB, vB); PG8_STAGE(PG8_SB(0, 1), cB + hB, vB); PG8_STAGE(PG8_SA(0, 0), cA, vA[0]); PG8_STAGE(PG8_SA(0, 1), cA, vA[1]);
            if (wr == 1) PG8_BAR;
            PG8_WAIT_V(2); PG8_BAR;
            PG8_STAGE(PG8_SB(1, 0), cB + kstep, vB); PG8_STAGE(PG8_SA(1, 0), cA + kstep, vA[0]); PG8_STAGE(PG8_SB(1, 1), cB + hB + kstep, vB);
            PG8_WAIT_V(6); PG8_BAR;
            fresh = false;
        }
        const bool has_next = S.next(ui + 1, nxt);
        const bool chain = has_next && !nxt.restart;
        const bool same_rows = chain && nxt.gather && cur.gather && nxt.slot0 == cur.slot0;
        const bool need_tok = chain && nxt.gather && !same_rows;
        const bool pf = (cur.kind == 1 && cur.sub == 2);
        if (pf && wid < 4) {
            const int s1 = cur.slot0 + S.G * 256; const bool ok = (S.w + (cur.mu + 1) * S.G) < BLK_PER_CH;
            PG8_LAS int* dc = tcode + ((cur.mu + 1) & 1) * 256 + wid * 64; PG8_LAS float* dg = tgate + ((cur.mu + 1) & 1) * 256 + wid * 64;
            int t_ = tid; asm volatile("" : "+v"(t_));
            if (ok) { __builtin_amdgcn_global_load_lds((const unsigned*)(stok + s1) + t_, (PG8_LAS unsigned*)dc, 4, 0, 0); __builtin_amdgcn_global_load_lds((const unsigned*)(sgate + s1) + t_, (PG8_LAS unsigned*)dg, 4, 0, 0); }
            else { dc[t_ & 63] = -1; dg[t_ & 63] = 0.f; }
        }
        const char* nA = chain ? nxt.A : cA; const char* nB = chain ? nxt.B : cB;
        const int nt = cur.nt;
#pragma nounroll
        for (int t = 0; t < nt; t += 2) {
            const bool last = (t == nt - 2);
            const char* a1 = cA + (size_t)(t + 1) * kstep;
            const char* a2 = last ? nA : cA + (size_t)(t + 2) * kstep; const char* b2 = last ? nB : cB + (size_t)(t + 2) * kstep;
            const char* a3 = a2 + kstep; const char* b3 = b2 + kstep;
            const int first = __builtin_amdgcn_readfirstlane((int)(post && t == 0));
            PG8_LDB(B0, 0, 0); PG8_LDB(B1, 0, 1); PG8_SCHED; PG8_LDA(At, 0, 0); PG8_STAGE_UNLESS(first, PG8_SA(1, 1), a1, vA[1]);
            PG8_WAIT_VF(first); PG8_WAIT_L(0); PG8_BAR; PG8_MMA(0, 0, At, B0); PG8_MMA(0, 1, At, B1);
            if (last && chain) MOE_OFFS(vA, vB, hB, nxt, need_tok, same_rows);
            PG8_BAR; PG8_SCHED;
            PG8_LDA(At, 0, 1); PG8_STAGE(PG8_SB(0, 0), b2, vB); PG8_STAGE(PG8_SB(0, 1), b2 + hB, vB); PG8_STAGE(PG8_SA(0, 0), a2, vA[0]);
            PG8_WAIT_VF(first); PG8_WAIT_L(0); PG8_BAR; PG8_MMA(1, 0, At, B0); PG8_MMA(1, 1, At, B1); PG8_BAR; PG8_SCHED;
            PG8_LDB(B0, 1, 0); PG8_LDB(B1, 1, 1); PG8_SCHED; PG8_LDA(At, 1, 0); PG8_STAGE(PG8_SA(0, 1), a2, vA[1]);
            PG8_WAIT_VF(first); PG8_WAIT_L(0); PG8_BAR; PG8_MMA(0, 0, At, B0); PG8_MMA(0, 1, At, B1); PG8_BAR; PG8_SCHED;
            PG8_LDA(At, 1, 1); PG8_STAGE(PG8_SB(1, 0), b3, vB); PG8_STAGE(PG8_SB(1, 1), b3 + hB, vB); PG8_STAGE(PG8_SA(1, 0), a3, vA[0]);
            PG8_WAIT_V(8); PG8_WAIT_L(0); PG8_BAR; PG8_MMA(1, 0, At, B0); PG8_MMA(1, 1, At, B1); PG8_BAR; PG8_SCHED;
        }
        if (wr == 0) PG8_BAR;
        if (chain) PG8_STAGE(PG8_SA(1, 1), nA + kstep, vA[1]);
        { int t_ = tid; asm volatile("" : "+v"(t_)); const int fr_ = t_ & 15, fq_ = (t_ >> 4) & 3;
          if (cur.kind == 0) e1(acc, cur, wr, wc, fr_, fq_); else e2(acc, cur, wr, wc, fr_, fq_); }
        if (!has_next) break;
#pragma unroll
        for (int a = 0; a < 2; ++a)
#pragma unroll
            for (int b = 0; b < 2; ++b)
#pragma unroll
                for (int m = 0; m < 4; ++m)
#pragma unroll
                    for (int n = 0; n < 2; ++n) acc[a][b][m][n] = (f32x4){0.f, 0.f, 0.f, 0.f};
        ++ui;
        post = chain;
        if (chain) { cur = nxt; if (wr == 1) PG8_BAR; }
        else {
            PG8_WAIT_V(0); PG8_BAR;
            cur = nxt;
            MOE_OFFS(vA, vB, hB, cur, cur.gather, false);
            fresh = true;
        }
    }
    PG8_WAIT_V(0);
    PG8_BAR;
#undef MOE_GEOM
#undef PG8_WAIT_VF
#undef PG8_STAGE_UNLESS
#undef MOE_OFFS
#undef PG8_SA
#undef PG8_SB
#undef PG8_STAGE
#undef PG8_LDA
#undef PG8_LDB
#undef PG8_MMA
#undef PG8_CAT
#undef PG8_WAIT_V
#undef PG8_WAIT_L
#undef PG8_BAR
#undef PG8_SCHED
}
struct EpiT1 {
    const LAS float* tgate; char* acts;
    __device__ __forceinline__ void operator()(const pg8::f32x4 (&acc)[2][2][4][2], const MUnit& u, int wr, int wc, int fr, int fq) const {
        int fr_ = fr, fq_ = fq; asm volatile("" : "+v"(fr_), "+v"(fq_)); const int r0 = wr * 64 + fr_;
        const unsigned off0 = (unsigned)r0 * 256u + (unsigned)(u.sub * 128 + wc * 32 + 8 * fq_);
        constexpr float IS = 1.f / (SC_H2 * SC_WGU);
#pragma unroll
        for (int ai = 0; ai < 2; ++ai)
#pragma unroll
            for (int m = 0; m < 4; ++m) { const float gw2 = tgate[(u.mu & 1) * 256 + r0 + ai * 128 + m * 16] * (SC_ACT * IS * IS); float v[8];
#pragma unroll
                for (int n = 0; n < 2; ++n)
#pragma unroll
                    for (int i = 0; i < 4; ++i) { const float ag = acc[ai][0][m][n][i], au = acc[ai][1][m][n][i];
                        v[4 * n + i] = (ag * au) * gw2 * __builtin_amdgcn_rcpf(1.f + __builtin_amdgcn_exp2f(ag * (-IS * 1.44269504f))); }
                v2u o; o.x = pk4_fp8(v[0], v[1], v[2], v[3]); o.y = pk4_fp8(v[4], v[5], v[6], v[7]);
                *(v2u*)(acts + (off0 + (unsigned)(ai * 128 + m * 16) * 256u)) = o; }
    }
};
constexpr int MOE_NST = 8;
struct EpiT2 {
    const LAS int* tcode; char* yt; int code0;
    __device__ __forceinline__ void operator()(const pg8::f32x4 (&acc)[2][2][4][2], const MUnit& u, int wr, int wc, int fr, int fq) const {
        int fr_ = fr, fq_ = fq; asm volatile("" : "+v"(fr_), "+v"(fq_)); const int r0 = wr * 64 + fr_;
        const unsigned colb = (unsigned)(u.sub * 256 + wc * 64 + 16 * fq_);
#pragma unroll
        for (int ai = 0; ai < 2; ++ai)
#pragma unroll
            for (int m = 0; m < 4; ++m) { const int code = tcode[(u.mu & 1) * 256 + r0 + ai * 128 + m * 16];
                char* rowp = yt + (size_t)(unsigned)(code >= 0 ? code - code0 : CH_TOK * TOPK) * 1024u + colb; v4u o;
#pragma unroll
                for (int bj = 0; bj < 2; ++bj) { static_assert(YT_SCALE == SC_ACT * SC_WD, "scales"); pg8::f32x4 v0 = acc[ai][bj][m][0], v1 = acc[ai][bj][m][1];
#pragma unroll
                    for (int j = 0; j < 4; ++j) { v0[j] = __builtin_amdgcn_fmed3f(v0[j], -448.f, 448.f); v1[j] = __builtin_amdgcn_fmed3f(v1[j], -448.f, 448.f); }
                    const unsigned lo = (unsigned)__builtin_amdgcn_cvt_pk_fp8_f32(v0[2], v0[3], __builtin_amdgcn_cvt_pk_fp8_f32(v0[0], v0[1], 0, false), true);
                    const unsigned hi = (unsigned)__builtin_amdgcn_cvt_pk_fp8_f32(v1[2], v1[3], __builtin_amdgcn_cvt_pk_fp8_f32(v1[0], v1[1], 0, false), true);
                    if (bj == 0) { o.x = lo; o.y = hi; } else { o.z = lo; o.w = hi; } }
                *(v4u*)rowp = o; }
    }
};
__device__ __forceinline__ void combine_row(const bf16* xm, float* orow, const char* yt_tok, const float* gate2, const float* fg, int lane) {
    typedef float f2 __attribute__((ext_vector_type(2)));
    float x[16], a[16];
#pragma unroll
    for (int h = 0; h < 2; ++h) { const v4u w = *(const v4u*)(xm + 16 * lane + 8 * h);
        x[8 * h + 0] = __uint_as_float(w.x << 16); x[8 * h + 1] = __uint_as_float(w.x & 0xffff0000u); x[8 * h + 2] = __uint_as_float(w.y << 16); x[8 * h + 3] = __uint_as_float(w.y & 0xffff0000u);
        x[8 * h + 4] = __uint_as_float(w.z << 16); x[8 * h + 5] = __uint_as_float(w.z & 0xffff0000u); x[8 * h + 6] = __uint_as_float(w.w << 16); x[8 * h + 7] = __uint_as_float(w.w & 0xffff0000u); }
#pragma unroll
    for (int j = 0; j < 16; ++j) a[j] = 0.f;
#pragma unroll
    for (int k = 0; k < TOPK; ++k) { const v4u w = *(const v4u*)(yt_tok + (size_t)k * 1024 + 16 * lane);
#pragma unroll
        for (int q = 0; q < 4; ++q) { const f2 lo = __builtin_amdgcn_cvt_pk_f32_fp8((int)w[q], false), hi = __builtin_amdgcn_cvt_pk_f32_fp8((int)w[q], true);
            a[4 * q + 0] += lo[0]; a[4 * q + 1] += lo[1]; a[4 * q + 2] += hi[0]; a[4 * q + 3] += hi[1]; } }
    float ss = 0.f;
#pragma unroll
    for (int q = 0; q < 4; ++q) { const f32x4 g2 = *(const f32x4*)(gate2 + 16 * lane + 4 * q);
#pragma unroll
        for (int j = 0; j < 4; ++j) { x[4 * q + j] += g2[j] * a[4 * q + j] * (1.f / YT_SCALE); ss += x[4 * q + j] * x[4 * q + j]; } }
    const float rstd = 1.f / sqrtf(wave_sum(ss) * (1.f / DM) + NORM_EPS);
#pragma unroll
    for (int q = 0; q < 4; ++q) { const f32x4 g = *(const f32x4*)(fg + 16 * lane + 4 * q);
        *(f32x4*)(orow + 16 * lane + 4 * q) = (f32x4){x[4 * q] * rstd * g[0], x[4 * q + 1] * rstd * g[1], x[4 * q + 2] * rstd * g[2], x[4 * q + 3] * rstd * g[3]}; }
}
__device__ __forceinline__ void combine_row_r(const bf16* xm, float* orow, const char* yt_tok, const f32x4 (&g2v)[4], const f32x4 (&fgv)[4], int lane) {
    typedef float f2 __attribute__((ext_vector_type(2)));
    float x[16], a[16];
#pragma unroll
    for (int h = 0; h < 2; ++h) { const v4u w = *(const v4u*)(xm + 16 * lane + 8 * h);
        x[8 * h + 0] = __uint_as_float(w.x << 16); x[8 * h + 1] = __uint_as_float(w.x & 0xffff0000u); x[8 * h + 2] = __uint_as_float(w.y << 16); x[8 * h + 3] = __uint_as_float(w.y & 0xffff0000u);
        x[8 * h + 4] = __uint_as_float(w.z << 16); x[8 * h + 5] = __uint_as_float(w.z & 0xffff0000u); x[8 * h + 6] = __uint_as_float(w.w << 16); x[8 * h + 7] = __uint_as_float(w.w & 0xffff0000u); }
#pragma unroll
    for (int j = 0; j < 16; ++j) a[j] = 0.f;
#pragma unroll
    for (int k = 0; k < TOPK; ++k) { const v4u w = *(const v4u*)(yt_tok + (size_t)k * 1024 + 16 * lane);
#pragma unroll
        for (int q = 0; q < 4; ++q) { const f2 lo = __builtin_amdgcn_cvt_pk_f32_fp8((int)w[q], false), hi = __builtin_amdgcn_cvt_pk_f32_fp8((int)w[q], true);
            a[4 * q + 0] += lo[0]; a[4 * q + 1] += lo[1]; a[4 * q + 2] += hi[0]; a[4 * q + 3] += hi[1]; } }
    float ss = 0.f;
#pragma unroll
    for (int q = 0; q < 4; ++q) {
#pragma unroll
        for (int j = 0; j < 4; ++j) { x[4 * q + j] += g2v[q][j] * a[4 * q + j]; ss += x[4 * q + j] * x[4 * q + j]; } }
    const float rstd = 1.f / sqrtf(wave_sum(ss) * (1.f / DM) + NORM_EPS);
#pragma unroll
    for (int q = 0; q < 4; ++q) { const f32x4 g = fgv[q];
        *(f32x4*)(orow + 16 * lane + 4 * q) = (f32x4){x[4 * q] * rstd * g[0], x[4 * q + 1] * rstd * g[1], x[4 * q + 2] * rstd * g[2], x[4 * q + 3] * rstd * g[3]}; }
}


__device__ __forceinline__ void dil_simple_item(const bf16* QA, const bf16* KA, const bf16* VA, bf16* ATT, int b, int hh, int t) {
    const size_t row = (size_t)b * SEQ + t;
    float q[64], o[64];
#pragma unroll
    for (int d = 0; d < 64; ++d) o[d] = 0.f;
    float m = -1e30f, l = 0.f;
    for (int g = 0; g < 3; ++g) {
        const int dil = (g == 0) ? 1 : (g == 1) ? 4 : 16; const int hc = (g * 4 + hh) * 64;
#pragma unroll
        for (int d8 = 0; d8 < 8; ++d8) { const v4u w = *(const v4u*)(QA + row * DILW + hc + 8 * d8);
            q[8 * d8 + 0] = __uint_as_float(w.x << 16); q[8 * d8 + 1] = __uint_as_float(w.x & 0xffff0000u); q[8 * d8 + 2] = __uint_as_float(w.y << 16); q[8 * d8 + 3] = __uint_as_float(w.y & 0xffff0000u);
            q[8 * d8 + 4] = __uint_as_float(w.z << 16); q[8 * d8 + 5] = __uint_as_float(w.z & 0xffff0000u); q[8 * d8 + 6] = __uint_as_float(w.w << 16); q[8 * d8 + 7] = __uint_as_float(w.w & 0xffff0000u); }
        for (int j = -64; j <= 64; ++j) {
            const int t2 = t + j * dil; if (t2 < 0 || t2 >= SEQ) continue;
            const bf16* kr = KA + ((size_t)b * SEQ + t2) * DILW + hc; const bf16* vr = VA + ((size_t)b * SEQ + t2) * DILW + hc;
            float s = 0.f;
#pragma unroll
            for (int d8 = 0; d8 < 8; ++d8) { const v4u w = *(const v4u*)(kr + 8 * d8);
                s += q[8 * d8 + 0] * __uint_as_float(w.x << 16) + q[8 * d8 + 1] * __uint_as_float(w.x & 0xffff0000u) + q[8 * d8 + 2] * __uint_as_float(w.y << 16) + q[8 * d8 + 3] * __uint_as_float(w.y & 0xffff0000u)
                   + q[8 * d8 + 4] * __uint_as_float(w.z << 16) + q[8 * d8 + 5] * __uint_as_float(w.z & 0xffff0000u) + q[8 * d8 + 6] * __uint_as_float(w.w << 16) + q[8 * d8 + 7] * __uint_as_float(w.w & 0xffff0000u); }
            const float mn = fmaxf(m, s), corr = exp2f(m - mn), p = exp2f(s - mn);
            l = l * corr + p; m = mn;
#pragma unroll
            for (int d8 = 0; d8 < 8; ++d8) { const v4u w = *(const v4u*)(vr + 8 * d8);
                o[8 * d8 + 0] = o[8 * d8 + 0] * corr + p * __uint_as_float(w.x << 16); o[8 * d8 + 1] = o[8 * d8 + 1] * corr + p * __uint_as_float(w.x & 0xffff0000u);
                o[8 * d8 + 2] = o[8 * d8 + 2] * corr + p * __uint_as_float(w.y << 16); o[8 * d8 + 3] = o[8 * d8 + 3] * corr + p * __uint_as_float(w.y & 0xffff0000u);
                o[8 * d8 + 4] = o[8 * d8 + 4] * corr + p * __uint_as_float(w.z << 16); o[8 * d8 + 5] = o[8 * d8 + 5] * corr + p * __uint_as_float(w.z & 0xffff0000u);
                o[8 * d8 + 6] = o[8 * d8 + 6] * corr + p * __uint_as_float(w.w << 16); o[8 * d8 + 7] = o[8 * d8 + 7] * corr + p * __uint_as_float(w.w & 0xffff0000u); }
        }
    }
    const float il = 1.f / l;
#pragma unroll
    for (int d8 = 0; d8 < 8; ++d8) { v4u w; w.x = pk2(o[8 * d8] * il, o[8 * d8 + 1] * il); w.y = pk2(o[8 * d8 + 2] * il, o[8 * d8 + 3] * il); w.z = pk2(o[8 * d8 + 4] * il, o[8 * d8 + 5] * il); w.w = pk2(o[8 * d8 + 6] * il, o[8 * d8 + 7] * il);
        *(v4u*)(ATT + row * 1280 + hh * 64 + 8 * d8) = w; }
}


constexpr size_t WS_OG = 912 * MiB;
constexpr size_t WS_LSE = 1008 * MiB;
typedef float f32x16 __attribute__((ext_vector_type(16)));
typedef short s16x4v __attribute__((ext_vector_type(4)));
__device__ __forceinline__ void dil_tile(const bf16* QA, const bf16* KA, const bf16* VA, bf16* OG, float* LSE, LAS unsigned char* vl, int b, int g, int hh, int r, int ub, int lane) {
    asm volatile("" : "+v"(lane));
    const int dil = (g == 0) ? 1 : (g == 1) ? 4 : 16, L = SEQ / dil, hc = (g * 4 + hh) * 64;
    const int r32 = lane & 31, hi = lane >> 5;
    const size_t rowb = (size_t)b * SEQ;
    const int tq = (32 * ub + r32) * dil + r;
    pg8::bf16x8 qf[4];
    { LAS unsigned char* slot = vl + 4608;
#pragma unroll
      for (int i = 0; i < 4; ++i) { const int id = i * 64 + lane, row = id >> 3, ch = id & 7;
          const v4u w = *(const v4u*)(QA + (rowb + (size_t)((32 * ub + row) * dil + r)) * DILW + hc + 8 * ch); *(LAS v4u*)(slot + row * 144 + ch * 16) = w; }
#pragma unroll
      for (int d0 = 0; d0 < 4; ++d0) qf[d0] = *(const LAS pg8::bf16x8*)(slot + r32 * 144 + (16 * d0 + 8 * hi) * 2); }
    f32x16 sc[5];
#pragma unroll
    for (int kvb = 0; kvb < 5; ++kvb) {
        LAS unsigned char* slot = vl + (kvb & 1) * 4608;
#pragma unroll
        for (int i = 0; i < 4; ++i) { const int id = i * 64 + lane, row = id >> 3, ch = id & 7; int uk = 32 * ub - 64 + 32 * kvb + row; uk = uk < 0 ? 0 : (uk > L - 1 ? L - 1 : uk);
            const v4u w = *(const v4u*)(KA + (rowb + (size_t)(uk * dil + r)) * DILW + hc + 8 * ch); *(LAS v4u*)(slot + row * 144 + ch * 16) = w; }
        f32x16 a = {};
#pragma unroll
        for (int d0 = 0; d0 < 4; ++d0) { const pg8::bf16x8 kf = *(const LAS pg8::bf16x8*)(slot + r32 * 144 + (16 * d0 + 8 * hi) * 2); a = __builtin_amdgcn_mfma_f32_32x32x16_bf16(kf, qf[d0], a, 0, 0, 0); }
        sc[kvb] = a;
    }
    float m = -INFINITY;
#pragma unroll
    for (int kvb = 0; kvb < 5; ++kvb)
#pragma unroll
        for (int rg = 0; rg < 16; ++rg) { const int kvl = (rg & 3) + 8 * (rg >> 2) + 4 * hi; const int du = -64 + 32 * kvb + kvl - r32; const int uu = 32 * ub + r32 + du;
            const bool ok = (du >= -64) && (du <= 64) && (uu >= 0) && (uu < L); const float v = ok ? sc[kvb][rg] : -INFINITY; sc[kvb][rg] = v; m = fmaxf(m, v); }
    m = fmaxf(m, __shfl_xor(m, 32));
    float l = 0.f;
#pragma unroll
    for (int kvb = 0; kvb < 5; ++kvb)
#pragma unroll
        for (int rg = 0; rg < 16; ++rg) { const float p = exp2f(sc[kvb][rg] - m); sc[kvb][rg] = p; l += p; }
    l += __shfl_xor(l, 32);
    f32x16 o0 = {}, o1 = {};
    const int g16 = lane >> 4, chalf = g16 & 1, q4 = (lane & 15) >> 2, p4 = lane & 3;
#pragma unroll
    for (int kvb = 0; kvb < 5; ++kvb) {
        LAS unsigned char* slot = vl + (kvb & 1) * 4608;
#pragma unroll
        for (int i = 0; i < 4; ++i) { const int id = i * 64 + lane, row = id >> 3, ch = id & 7; int uv = 32 * ub - 64 + 32 * kvb + row; uv = uv < 0 ? 0 : (uv > L - 1 ? L - 1 : uv);
            const v4u w = *(const v4u*)(VA + (rowb + (size_t)(uv * dil + r)) * DILW + hc + 8 * ch); *(LAS v4u*)(slot + row * 144 + ch * 16) = w; }
#pragma unroll
        for (int st = 0; st < 2; ++st) {
            pg8::u32x4 pw; pw.x = pg8::cvt_pk_bf16(sc[kvb][8 * st + 0], sc[kvb][8 * st + 1]); pw.y = pg8::cvt_pk_bf16(sc[kvb][8 * st + 2], sc[kvb][8 * st + 3]);
            pw.z = pg8::cvt_pk_bf16(sc[kvb][8 * st + 4], sc[kvb][8 * st + 5]); pw.w = pg8::cvt_pk_bf16(sc[kvb][8 * st + 6], sc[kvb][8 * st + 7]);
            const pg8::bf16x8 pa = __builtin_bit_cast(pg8::bf16x8, pw);
#pragma unroll
            for (int dh = 0; dh < 2; ++dh) {
                LAS unsigned char* ap = slot + (16 * st + 4 * hi + q4) * 144 + (32 * dh + 16 * chalf + 4 * p4) * 2;
                const s16x4v lo = __builtin_bit_cast(s16x4v, __builtin_amdgcn_ds_read_tr16_b64_v4i16((LAS s16x4v*)ap));
                const s16x4v hv = __builtin_bit_cast(s16x4v, __builtin_amdgcn_ds_read_tr16_b64_v4i16((LAS s16x4v*)(ap + 8 * 144)));
                const pg8::bf16x8 vf = (pg8::bf16x8){lo[0], lo[1], lo[2], lo[3], hv[0], hv[1], hv[2], hv[3]};
                if (dh == 0) o0 = __builtin_amdgcn_mfma_f32_32x32x16_bf16(pa, vf, o0, 0, 0, 0); else o1 = __builtin_amdgcn_mfma_f32_32x32x16_bf16(pa, vf, o1, 0, 0, 0);
            }
        }
    }
    const float il = 1.f / l;
    if (hi == 0) LSE[((size_t)g * NT + rowb + tq) * 4 + hh] = m + log2f(l);
    unsigned char* og = (unsigned char*)OG + (size_t)g * NT * 256;
#pragma unroll
    for (int rg = 0; rg < 16; ++rg) { const int q = (rg & 3) + 8 * (rg >> 2) + 4 * hi; const float ilq = __shfl(il, q);
        *(LAS bf16*)(vl + q * 144 + r32 * 2) = f2bf(o0[rg] * ilq); *(LAS bf16*)(vl + q * 144 + 64 + r32 * 2) = f2bf(o1[rg] * ilq); }
#pragma unroll
    for (int i = 0; i < 2; ++i) { const int id = i * 64 + lane, row = id >> 2, c16 = id & 3; const v4u wa = *(const LAS v4u*)(vl + row * 144 + c16 * 32), wb = *(const LAS v4u*)(vl + row * 144 + c16 * 32 + 16);
        v4u o;
#pragma unroll
        for (int k = 0; k < 2; ++k) { o[k] = pk4_fp8(__uint_as_float(wa[2 * k] << 16) * SC_ATT, __uint_as_float(wa[2 * k] & 0xffff0000u) * SC_ATT, __uint_as_float(wa[2 * k + 1] << 16) * SC_ATT, __uint_as_float(wa[2 * k + 1] & 0xffff0000u) * SC_ATT);
            o[2 + k] = pk4_fp8(__uint_as_float(wb[2 * k] << 16) * SC_ATT, __uint_as_float(wb[2 * k] & 0xffff0000u) * SC_ATT, __uint_as_float(wb[2 * k + 1] << 16) * SC_ATT, __uint_as_float(wb[2 * k + 1] & 0xffff0000u) * SC_ATT); }
        *(v4u*)(og + (rowb + (size_t)((32 * ub + row) * dil + r)) * 256 + hh * 64 + 16 * c16) = o; }
}
__device__ __forceinline__ void dil_phase(Frame& F, const bf16* QA, const bf16* KA, const bf16* VA, bf16* OG, float* LSE, bf16* ATT) {
    LAS unsigned char* vl = F.lds + F.wave * 9216;
    for (int unit = F.vcu; unit < NB * 16; unit += F.G) {
        const int b = unit >> 4, hh = (unit >> 2) & 3, tb = unit & 3;
        for (int wt = F.wave; wt < 48; wt += NWAVES) { const int g = wt >> 4, j = wt & 15;
            const int r = (g == 0) ? 0 : (g == 1) ? (j & 3) : j; const int ub = (g == 0) ? 16 * tb + j : (g == 1) ? 4 * tb + (j >> 2) : tb;
            dil_tile(QA, KA, VA, OG, LSE, vl, b, g, hh, r, ub, F.lane); }
        VM_WAIT(); __syncthreads();
        {
            typedef float f2_ __attribute__((ext_vector_type(2)));
            const unsigned char* og8 = (const unsigned char*)OG;
#pragma unroll
            for (int it = 0; it < 4; ++it) { const int tk = it * 128 + (F.tid >> 2), c16 = F.tid & 3;
                const size_t row = (size_t)b * SEQ + 512 * tb + tk;
                const float l0 = LSE[(row) * 4 + hh], l1 = LSE[((size_t)NT + row) * 4 + hh], l2 = LSE[((size_t)2 * NT + row) * 4 + hh];
                const float mx = fmaxf(l0, fmaxf(l1, l2)); float w0 = exp2f(l0 - mx), w1 = exp2f(l1 - mx), w2 = exp2f(l2 - mx); const float iw = 1.f / (w0 + w1 + w2); w0 *= iw; w1 *= iw; w2 *= iw;
                const v4u a = *(const v4u*)(og8 + row * 256 + hh * 64 + 16 * c16), bb = *(const v4u*)(og8 + ((size_t)NT + row) * 256 + hh * 64 + 16 * c16), c = *(const v4u*)(og8 + ((size_t)2 * NT + row) * 256 + hh * 64 + 16 * c16);
                v4u o;
#pragma unroll
                for (int k = 0; k < 4; ++k) { const f2_ al = __builtin_amdgcn_cvt_pk_f32_fp8((int)a[k], false), ah = __builtin_amdgcn_cvt_pk_f32_fp8((int)a[k], true), bl = __builtin_amdgcn_cvt_pk_f32_fp8((int)bb[k], false), bh = __builtin_amdgcn_cvt_pk_f32_fp8((int)bb[k], true),
                        cl = __builtin_amdgcn_cvt_pk_f32_fp8((int)c[k], false), ch_ = __builtin_amdgcn_cvt_pk_f32_fp8((int)c[k], true);
                    o[k] = pk4_fp8(w0 * al[0] + w1 * bl[0] + w2 * cl[0], w0 * al[1] + w1 * bl[1] + w2 * cl[1], w0 * ah[0] + w1 * bh[0] + w2 * ch_[0], w0 * ah[1] + w1 * bh[1] + w2 * ch_[1]); }
                *(v4u*)((unsigned char*)ATT + row * 1280 + hh * 64 + 16 * c16) = o; }
        }
    }
    __syncthreads();
}


__device__ __forceinline__ float sigmoid_rcp_(float x) { return __builtin_amdgcn_rcpf(1.f + __expf(-x)); }
__device__ __forceinline__ void topk_panel(Frame& F, const float* LOGITS, const float* rbias, int p, int* IDX, float* GATEV, int* POSE, int* counts) {
    typedef float f4 __attribute__((ext_vector_type(4)));
    LAS f4* sl = (LAS f4*)F.lds;
    LAS f4* sb = (LAS f4*)(F.lds + MOE_LDS_OFF);
    if (F.tid < 64) sb[F.tid] = *(const f4*)(rbias + 4 * F.tid);
    for (int half = 0; half < 2; ++half) {
        __syncthreads();
        const float* src = LOGITS + (size_t)(p * 256 + half * 128) * NEXP;
#pragma unroll 4
        for (int i = 0; i < 16; ++i) { const int id = i * 512 + F.tid, row = id >> 6, c4 = id & 63; sl[row * 64 + (c4 ^ (row & 63))] = *(const f4*)(src + (size_t)row * NEXP + 4 * c4); }
        __syncthreads();
        if (F.tid < 128) {
            const int row = F.tid, sw = row & 63; const LAS f4* rp = sl + row * 64;
            float gs[8];
#pragma unroll
            for (int g = 0; g < 8; ++g) { float m1 = -INFINITY, m2 = -INFINITY;
#pragma unroll
                for (int c = 0; c < 8; ++c) { const f4 lg = rp[(8 * g + c) ^ sw], bb = sb[8 * g + c];
#pragma unroll
                    for (int j = 0; j < 4; ++j) { const float v = sigmoid_rcp_(lg[j]) + bb[j]; const float lo = fminf(m1, v); m1 = fmaxf(m1, v); m2 = fmaxf(m2, lo); } }
                gs[g] = m1 + m2; }
            unsigned mask = 0u;
#pragma unroll
            for (int g = 0; g < 8; ++g) { int rank = 0;
#pragma unroll
                for (int g2 = 0; g2 < 8; ++g2) rank += (gs[g2] > gs[g] || (gs[g2] == gs[g] && g2 < g)) ? 1 : 0;
                mask |= (rank < 4) ? (1u << g) : 0u; }
            float tv[8]; int ti[8];
#pragma unroll
            for (int k = 0; k < 8; ++k) { tv[k] = -INFINITY; ti[k] = 0; }
#pragma unroll 1
            for (int jg = 0; jg < 4; ++jg) { const int g = __ffs(mask) - 1; mask &= mask - 1u;
#pragma unroll 2
                for (int c = 0; c < 8; ++c) { const f4 lg = rp[(8 * g + c) ^ sw], bb = sb[8 * g + c];
#pragma unroll
                    for (int j = 0; j < 4; ++j) { float cv = sigmoid_rcp_(lg[j]) + bb[j]; int ci = 32 * g + 4 * c + j;
#pragma unroll
                        for (int k = 0; k < 8; ++k) { const bool gt = cv > tv[k]; const float ov = tv[k]; const int oi = ti[k]; tv[k] = gt ? cv : ov; ti[k] = gt ? ci : oi; cv = gt ? ov : cv; ci = gt ? oi : ci; } } } }
            float sc[8]; float ssum = 0.f;
#pragma unroll
            for (int k = 0; k < 8; ++k) { const int e = ti[k]; const float lgv = ((const LAS float*)(rp + ((e >> 2) ^ sw)))[e & 3]; sc[k] = sigmoid_rcp_(lgv); ssum += sc[k]; }
            const int t = p * 256 + half * 128 + row; const int chunk = t / CH_TOK; const float inv = 2.5f / ssum;
            int ps[8];
#pragma unroll
            for (int k = 0; k < 8; ++k) ps[k] = atomicAdd(&counts[chunk * NEXP + ti[k]], 1);
            *(int4*)(IDX + (size_t)t * TOPK) = make_int4(ti[0], ti[1], ti[2], ti[3]); *(int4*)(IDX + (size_t)t * TOPK + 4) = make_int4(ti[4], ti[5], ti[6], ti[7]);
            *(float4*)(GATEV + (size_t)t * TOPK) = make_float4(sc[0] * inv, sc[1] * inv, sc[2] * inv, sc[3] * inv); *(float4*)(GATEV + (size_t)t * TOPK + 4) = make_float4(sc[4] * inv, sc[5] * inv, sc[6] * inv, sc[7] * inv);
            *(int4*)(POSE + (size_t)t * TOPK) = make_int4(ps[0], ps[1], ps[2], ps[3]); *(int4*)(POSE + (size_t)t * TOPK + 4) = make_int4(ps[4], ps[5], ps[6], ps[7]);
        }
    }
    __syncthreads();
}

__device__ __forceinline__ void ph_mod(Frame& F, const float* c, const float* w_ada, const float* b_ada, float* MOD) {
    LAS float* sc = (LAS float*)(F.lds + F.wave * 16384);
    for (int unit = F.vcu; unit < 96; unit += F.G) {
        const int k0 = F.wave * 128;
        for (int e = F.lane; e < 32 * 128; e += 64) { const int b = e >> 7, kk = e & 127; const float cv = c[b * DM + k0 + kk]; sc[e] = cv / (1.f + __expf(-cv)); }
        LDS_WAIT();
        float acc[32];
#pragma unroll
        for (int b = 0; b < 32; ++b) acc[b] = 0.f;
        const float* wp = w_ada + (size_t)k0 * 6144 + unit * 64 + F.lane;
        for (int kk = 0; kk < 128; ++kk) { const float w = wp[(size_t)kk * 6144];
#pragma unroll
            for (int b = 0; b < 32; ++b) acc[b] += sc[b * 128 + kk] * w; }
        __syncthreads();
        LAS float* part = (LAS float*)F.lds;
#pragma unroll
        for (int b = 0; b < 32; ++b) part[(F.wave * 32 + b) * 64 + F.lane] = acc[b];
        __syncthreads();
        for (int e = F.tid; e < 2048; e += 512) { float s = 0.f;
#pragma unroll
            for (int w = 0; w < 8; ++w) s += part[w * 2048 + e];
            const int b = e >> 6, j = unit * 64 + (e & 63); MOD[b * 6144 + j] = s + b_ada[j]; }
        __syncthreads();
    }
}
__device__ __forceinline__ void ph_tables(Frame& F, float* rope) {
    float* C1 = rope; float* S1 = rope + 65536; float* CR = rope + 131072; float* SR = CR + 512; float* CC = SR + 512; float* SC = CC + 1024;
    const int gt = F.vcu * 512 + F.tid, NG = F.G * 512;
    for (int idx = gt; idx < 65536; idx += NG) { const int t = idx >> 5, j = idx & 31; const double a = (double)t * pow(10000.0, -(double)j / 32.0); C1[idx] = (float)cos(a); S1[idx] = (float)sin(a); }
    for (int idx = gt; idx < 1024; idx += NG) { const int p = idx >> 4, j = idx & 15; const double a = (double)p * pow(10000.0, -(double)j / 16.0); const float cv = (float)cos(a), sv = (float)sin(a);
        CC[idx] = cv; SC[idx] = sv; if (idx < 512) { CR[idx] = cv; SR[idx] = sv; } }
}
__device__ __forceinline__ void norm_row_from_bf16(const bf16* xrow, const float* g, const float* shift, const float* scale, bf16* orow, unsigned char* o8, int lane) {
    f32x4 v[4]; float ss = 0.f;
#pragma unroll
    for (int h = 0; h < 2; ++h) { const v4u w = *(const v4u*)(xrow + 8 * lane + 512 * h);
        v[2 * h] = (f32x4){__uint_as_float(w.x << 16), __uint_as_float(w.x & 0xffff0000u), __uint_as_float(w.y << 16), __uint_as_float(w.y & 0xffff0000u)};
        v[2 * h + 1] = (f32x4){__uint_as_float(w.z << 16), __uint_as_float(w.z & 0xffff0000u), __uint_as_float(w.w << 16), __uint_as_float(w.w & 0xffff0000u)}; }
#pragma unroll
    for (int j = 0; j < 4; ++j) ss += (v[j].x * v[j].x + v[j].y * v[j].y) + (v[j].z * v[j].z + v[j].w * v[j].w);
    const float rstd = 1.f / sqrtf(wave_sum(ss) * (1.f / DM) + NORM_EPS);
#pragma unroll
    for (int h = 0; h < 2; ++h) { f32x4 y[2];
#pragma unroll
        for (int q = 0; q < 2; ++q) { const int cidx = 8 * lane + 512 * h + 4 * q; const f32x4 gg = *(const f32x4*)(g + cidx), sh = *(const f32x4*)(shift + cidx), sc = *(const f32x4*)(scale + cidx); y[q] = v[2 * h + q] * rstd * gg * (sc + 1.f) + sh; }
        v4u w; w.x = pk2(y[0].x, y[0].y); w.y = pk2(y[0].z, y[0].w); w.z = pk2(y[1].x, y[1].y); w.w = pk2(y[1].z, y[1].w);
        *(v4u*)(orow + 8 * lane + 512 * h) = w;
        if (o8) { v2u w8; w8.x = pk4_fp8(y[0].x * SC_H2, y[0].y * SC_H2, y[0].z * SC_H2, y[0].w * SC_H2); w8.y = pk4_fp8(y[1].x * SC_H2, y[1].y * SC_H2, y[1].z * SC_H2, y[1].w * SC_H2); *(v2u*)(o8 + 8 * lane + 512 * h) = w8; } }
}
__device__ __forceinline__ void norm_row_bf16(const float* xrow, const float* g, const float* shift, const float* scale, bf16* orow, int lane) {
    const GAS f32x4* xr = (const GAS f32x4*)xrow + lane;
    f32x4 v[4]; float ss = 0.f;
#pragma unroll
    for (int j = 0; j < 4; ++j) { v[j] = xr[64 * j]; ss += (v[j].x * v[j].x + v[j].y * v[j].y) + (v[j].z * v[j].z + v[j].w * v[j].w); }
    const float rstd = 1.f / sqrtf(wave_sum(ss) * (1.f / DM) + NORM_EPS);
    GAS v2u* o8 = (GAS v2u*)orow + lane;
#pragma unroll
    for (int j = 0; j < 4; ++j) { const int cidx = 4 * lane + 256 * j; const f32x4 gg = *(const f32x4*)(g + cidx), sh = *(const f32x4*)(shift + cidx), sc = *(const f32x4*)(scale + cidx);
        const f32x4 y = v[j] * rstd * gg * (sc + 1.f) + sh; v2u w; w.x = pk2(y.x, y.y); w.y = pk2(y.z, y.w); o8[64 * j] = w; }
}

__device__ __forceinline__ void norm_row_fp8(const float* xrow, const float* g, const float* shift, const float* scale, unsigned char* orow, int lane) {
    const GAS f32x4* xr = (const GAS f32x4*)xrow + lane;
    f32x4 v[4]; float ss = 0.f;
#pragma unroll
    for (int j = 0; j < 4; ++j) { v[j] = xr[64 * j]; ss += (v[j].x * v[j].x + v[j].y * v[j].y) + (v[j].z * v[j].z + v[j].w * v[j].w); }
    const float rstd = 1.f / sqrtf(wave_sum(ss) * (1.f / DM) + NORM_EPS);
    GAS unsigned* o4 = (GAS unsigned*)orow + lane;
#pragma unroll
    for (int j = 0; j < 4; ++j) { const int cidx = 4 * lane + 256 * j; const f32x4 gg = *(const f32x4*)(g + cidx), sh = *(const f32x4*)(shift + cidx), sc = *(const f32x4*)(scale + cidx);
        const f32x4 y = (v[j] * rstd * gg * (sc + 1.f) + sh) * SC_H1; o4[64 * j] = pk4_fp8(y.x, y.y, y.z, y.w); }
}

__global__ void __launch_bounds__(NWAVES * 64, 2) mk_fwd(Args args) {
    extern __shared__ __attribute__((aligned(16))) unsigned char lds[];
    Frame F;
    F.lds = (LAS unsigned char*)lds; F.MISC = (volatile LAS unsigned*)(F.lds + MISC_OFF); F.ws = args.ws;
    F.tid = threadIdx.x; F.lane = F.tid & 63; F.wave = __builtin_amdgcn_readfirstlane(F.tid >> 6); asm volatile("" : "+s"(F.wave));
    F.G = gridDim.x; { const int bx = blockIdx.x; F.vcu = (F.G % 8 == 0) ? (bx % 8) * (F.G / 8) + bx / 8 : bx; }
    unsigned char* ws = args.ws;
    for (int u = F.tid; u < (LDS_BYTES - LDSCTL_OFF) / 4; u += NWAVES * 64) ((LAS unsigned*)(F.lds + LDSCTL_OFF))[u] = 0u;
    __syncthreads();
    XcdBarrier bar = xcd_barrier_post((unsigned*)(ws + WS_CTL + WS_BAR) + args.li * XCD_BAR_WORDS, F.MISC + 8, F.wave);
    const int lo = args.ph_lo, hi = args.ph_hi;
#define IN(k) (lo <= (k) && (k) < hi)
#define PHASE_PIN() do { const int t_ = hw_tid(F.wave); F.tid = t_; F.lane = t_ & 63; } while (0)
#define BOTH(k) (IN(k) && IN((k) + 1))
    const float* x = args.in[0];
    float* MOD = (float*)(ws + WS_MOD); float* ROPE = (float*)(ws + WS_ROPE);
    unsigned char* H8 = (unsigned char*)args.out;
    bf16* DHI = (bf16*)args.out + (size_t)NT * DM;
    bf16* XMB = (bf16*)(ws + WS_A);
    const int gw = F.vcu * NWAVES + F.wave, NGW = F.G * NWAVES;

    if (IN(PH_PRO)) { PHASE_PIN();
        ph_mod(F, args.in[1], args.in[2], args.in[3], MOD);
        ph_tables(F, ROPE);
        LAS float* scr = (LAS float*)(F.lds + F.wave * 16384);
        constexpr int I_WIN = (DM / 64) * (INW / 32);
        for (int it = gw; it < I_WIN; it += NGW) p0_transpose_item8(args.in[5], DM, INW, ws + WS_WIN_T, DM, RmWin{}, scr, it, F.lane, SC_WIN);
        { constexpr int I_D = (256 / 64) * (DM / 32), I_G = (DM / 64) * (DM / 32);
          unsigned char* WC = ws + WS_WCAT_T; unsigned char* WO = ws + WS_WOUT_T;
          for (int it = gw; it < I_D + 2 * I_G; it += NGW) {
              if (it < I_D) p0_transpose_item8(args.in[9], 256, DM, WC, 1280, RmId{0}, scr, it, F.lane, SC_WMIX);
              else if (it < I_D + I_G) p0_transpose_item8(args.in[10], DM, DM, WC + 256, 1280, RmId{0}, scr, it - I_D, F.lane, SC_WMIX);
              else p0_transpose_item8(args.in[11], DM, DM, WO, DM, RmId{0}, scr, it - I_D - I_G, F.lane, SC_WMIX); } }
        { constexpr int I_R = (DM / 64) * (256 / 32), I_SD = (256 / 64) * (DM / 32);
          bf16* WR = (bf16*)(ws + WS_WRS_T); bf16* WD = (bf16*)(ws + WS_WSD_T);
          for (int it = gw; it < 3 * I_R + I_SD; it += NGW) {
              if (it < I_R) p0_transpose_item(args.in[13], DM, 256, WR, DM, RmId{0}, scr, it, F.lane);
              else if (it < 2 * I_R) p0_transpose_item(args.in[18], DM, 256, WR, DM, RmSh{256}, scr, it - I_R, F.lane);
              else if (it < 3 * I_R) p0_transpose_item(args.in[19], DM, 256, WR, DM, RmSh{384}, scr, it - 2 * I_R, F.lane);
              else p0_transpose_item(args.in[20], 256, DM, WD, 256, RmId{0}, scr, it - 3 * I_R, F.lane); } }
        if (BOTH(PH_PRO)) xcd_barrier(bar);
    }
    if (IN(PH_NORM1)) { PHASE_PIN();
        if (NT % NGW == 0 && SEQ % (NT / NGW) == 0) {
            constexpr float S1 = SC_H1; const int RPW = NT / NGW, m0 = gw * RPW, b = m0 / SEQ, lane = F.lane;
            const float* gp = args.in[4]; const float* shp = MOD + b * 6144; const float* scp = shp + DM;
            f32x4 ga[4], sh[4];
#pragma unroll
            for (int j = 0; j < 4; ++j) { const int cidx = 4 * lane + 256 * j; ga[j] = *(const f32x4*)(gp + cidx) * (*(const f32x4*)(scp + cidx) + 1.f) * S1; sh[j] = *(const f32x4*)(shp + cidx) * S1; }
            const GAS f32x4* xr = (const GAS f32x4*)(x + (size_t)m0 * DM) + lane; GAS unsigned* o4 = (GAS unsigned*)(H8 + (size_t)m0 * DM) + lane;
            f32x4 cur[4], nxt[4];
#pragma unroll
            for (int j = 0; j < 4; ++j) cur[j] = xr[64 * j];
            for (int i = 0; i < RPW; ++i) {
                if (i + 1 < RPW) {
#pragma unroll
                    for (int j = 0; j < 4; ++j) nxt[j] = xr[(size_t)(i + 1) * 256 + 64 * j]; }
                float ss = 0.f;
#pragma unroll
                for (int j = 0; j < 4; ++j) ss += (cur[j].x * cur[j].x + cur[j].y * cur[j].y) + (cur[j].z * cur[j].z + cur[j].w * cur[j].w);
                const float rstd = 1.f / sqrtf(wave_sum(ss) * (1.f / DM) + NORM_EPS);
#pragma unroll
                for (int j = 0; j < 4; ++j) { const f32x4 y = cur[j] * rstd * ga[j] + sh[j]; o4[(size_t)i * 256 + 64 * j] = pk4_fp8(y.x, y.y, y.z, y.w); }
#pragma unroll
                for (int j = 0; j < 4; ++j) cur[j] = nxt[j];
            }
        } else
        for (int m = gw; m < NT; m += NGW) { const int b = m / SEQ; norm_row_fp8(x + (size_t)m * DM, args.in[4], MOD + b * 6144, MOD + b * 6144 + DM, H8 + (size_t)m * DM, F.lane); }
        if (BOTH(PH_NORM1)) xcd_barrier(bar);
    }
    if (IN(PH_PROJ)) { PHASE_PIN();
        pg8::Gemm g{(const bf16*)H8, (const bf16*)(ws + WS_WIN_T), NT, INW, DM, DM, DM}; pg8::StaticOrder S; S.init(NT, INW, F.G, (int)blockIdx.x);
        EpiP1 E{ws, ROPE, args.in[7], args.in[8], args.in[6]};
        pg8::gemm_phase<EpiP1, pg8::StaticOrder>(F.lds, g, S, E, F.wave);
        if (BOTH(PH_PROJ)) xcd_barrier(bar);
    }
    if (IN(PH_ATT)) { PHASE_PIN();
        dil_phase(F, (const bf16*)(ws + WS_QA), (const bf16*)(ws + WS_KA), (const bf16*)(ws + WS_VA), (bf16*)(ws + WS_OG), (float*)(ws + WS_LSE), (bf16*)(ws + WS_ATT));
        __syncthreads();
        const attn_body::AttnTensors AT{(const attn_body::bf16*)(ws + WS_QB), (const attn_body::bf16*)(ws + WS_KB), (const attn_body::bf16*)(ws + WS_VB), (attn_body::bf16*)(ws + WS_ATT)};
        const attn_body::StaticOrder S(F.vcu, F.G);
        attn_body::attn_phase<attn_body::StaticOrder>((char*)lds, AT, S, F.wave);
        if (BOTH(PH_ATT)) xcd_barrier(bar);
    }
    if (IN(PH_MIX1)) { PHASE_PIN();
        pg8::Gemm g{(const bf16*)(ws + WS_ATT), (const bf16*)(ws + WS_WCAT_T), NT, DM, 1280, 1280, 1280}; pg8::StaticOrder S; S.init(NT, DM, F.G, (int)blockIdx.x);
        EpiGatedF E{(const bf16*)(ws + WS_GATES), (unsigned char*)DHI};
        pg8::gemm_phase<EpiGatedF, pg8::StaticOrder>(F.lds, g, S, E, F.wave);
        if (BOTH(PH_MIX1)) xcd_barrier(bar);
    }
    if (IN(PH_MIX2)) { PHASE_PIN();
        pg8::Gemm g{DHI, (const bf16*)(ws + WS_WOUT_T), NT, DM, DM, DM, DM}; pg8::StaticOrder S; S.init(NT, DM, F.G, (int)blockIdx.x);
        EpiXmidF E{x, MOD, XMB};
        pg8::gemm_phase<EpiXmidF, pg8::StaticOrder>(F.lds, g, S, E, F.wave);
        if (BOTH(PH_MIX2)) xcd_barrier(bar);
    }
    if (IN(PH_NORM2)) { PHASE_PIN();
        bf16* H2 = DHI; unsigned char* H2F = (unsigned char*)args.out;
        if (NT % NGW == 0 && SEQ % (NT / NGW) == 0) {
            const int RPW = NT / NGW, m0 = gw * RPW, b = m0 / SEQ, lane = F.lane;
            const float* gp = args.in[12]; const float* shp = MOD + b * 6144 + 3 * DM; const float* scp = MOD + b * 6144 + 4 * DM;
            f32x4 ga[4], sh[4];
#pragma unroll
            for (int j = 0; j < 4; ++j) { const int cidx = 8 * lane + 512 * (j >> 1) + 4 * (j & 1); ga[j] = *(const f32x4*)(gp + cidx) * (*(const f32x4*)(scp + cidx) + 1.f); sh[j] = *(const f32x4*)(shp + cidx); }
            const bf16* xr = XMB + (size_t)m0 * DM + 8 * lane; bf16* orow = H2 + (size_t)m0 * DM + 8 * lane; unsigned char* o8 = H2F + (size_t)m0 * DM + 8 * lane;
            v4u cur[2], nxt[2], nx2[2], nx3[2];
            cur[0] = *(const v4u*)xr; cur[1] = *(const v4u*)(xr + 512);
            if (RPW > 1) { nxt[0] = *(const v4u*)(xr + DM); nxt[1] = *(const v4u*)(xr + DM + 512); }
            if (RPW > 2) { nx2[0] = *(const v4u*)(xr + 2 * DM); nx2[1] = *(const v4u*)(xr + 2 * DM + 512); }
            for (int i = 0; i < RPW; ++i) {
                if (i + 3 < RPW) { nx3[0] = *(const v4u*)(xr + (size_t)(i + 3) * DM); nx3[1] = *(const v4u*)(xr + (size_t)(i + 3) * DM + 512); }
                f32x4 v[4]; float ss = 0.f;
#pragma unroll
                for (int h = 0; h < 2; ++h) { const v4u w = cur[h];
                    v[2 * h] = (f32x4){__uint_as_float(w.x << 16), __uint_as_float(w.x & 0xffff0000u), __uint_as_float(w.y << 16), __uint_as_float(w.y & 0xffff0000u)};
                    v[2 * h + 1] = (f32x4){__uint_as_float(w.z << 16), __uint_as_float(w.z & 0xffff0000u), __uint_as_float(w.w << 16), __uint_as_float(w.w & 0xffff0000u)}; }
#pragma unroll
                for (int j = 0; j < 4; ++j) ss += (v[j].x * v[j].x + v[j].y * v[j].y) + (v[j].z * v[j].z + v[j].w * v[j].w);
                const float rstd = 1.f / sqrtf(wave_sum(ss) * (1.f / DM) + NORM_EPS);
#pragma unroll
                for (int h = 0; h < 2; ++h) { const f32x4 y0 = v[2 * h] * rstd * ga[2 * h] + sh[2 * h], y1 = v[2 * h + 1] * rstd * ga[2 * h + 1] + sh[2 * h + 1];
                    v4u w; w.x = pk2(y0.x, y0.y); w.y = pk2(y0.z, y0.w); w.z = pk2(y1.x, y1.y); w.w = pk2(y1.z, y1.w);
                    *(v4u*)(orow + (size_t)i * DM + 512 * h) = w;
                    v2u w8; w8.x = pk4_fp8(y0.x * SC_H2, y0.y * SC_H2, y0.z * SC_H2, y0.w * SC_H2); w8.y = pk4_fp8(y1.x * SC_H2, y1.y * SC_H2, y1.z * SC_H2, y1.w * SC_H2); *(v2u*)(o8 + (size_t)i * DM + 512 * h) = w8; }
                cur[0] = nxt[0]; cur[1] = nxt[1]; nxt[0] = nx2[0]; nxt[1] = nx2[1]; nx2[0] = nx3[0]; nx2[1] = nx3[1];
            }
        } else
        for (int m = gw; m < NT; m += NGW) { const int b = m / SEQ; norm_row_from_bf16(XMB + (size_t)m * DM, args.in[12], MOD + b * 6144 + 3 * DM, MOD + b * 6144 + 4 * DM, H2 + (size_t)m * DM, H2F + (size_t)m * DM, F.lane); }
        { LAS float* scr = (LAS float*)(F.lds + F.wave * 16384);
          unsigned char* WGU = (unsigned char*)(ws + WS_WGU); unsigned char* WDN = (unsigned char*)(ws + WS_WD);
          for (int it = gw; it < NEXP * 384; it += NGW) { const int e = it / 384, r = it - e * 384;
              if (r < 128) p0_transpose_item8(args.in[15] + (size_t)e * DM * EFF, DM, EFF, WGU + (size_t)e * 512 * DM, DM, RmSh{0}, scr, r, F.lane, SC_WGU);
              else if (r < 256) p0_transpose_item8(args.in[16] + (size_t)e * DM * EFF, DM, EFF, WGU + (size_t)e * 512 * DM, DM, RmSh{128}, scr, r - 128, F.lane, SC_WGU);
              else p0_transpose_item8(args.in[17] + (size_t)e * EFF * DM, EFF, DM, WDN + (size_t)e * DM * EFF, EFF, RmId{0}, scr, r - 256, F.lane, SC_WD); } }
        if (BOTH(PH_NORM2)) xcd_barrier(bar);
    }
    if (IN(PH_RS)) { PHASE_PIN();
        const bf16* H2 = DHI; float* LOGITS = (float*)(ws + WS_LOGITS); bf16* SHACT = (bf16*)(ws + WS_SHACT);
        PanelOrder S; S.init(NT, 768, F.G, F.vcu);
        { pg8::Gemm g{H2, (const bf16*)(ws + WS_WRS_T), NT, 768, DM, DM, DM}; EpiRS E{LOGITS, SHACT};
          pg8::gemm_phase<EpiRS, PanelOrder>(F.lds, g, S, E, F.wave); }
        PHASE_PIN(); VM_WAIT(); __syncthreads();
        if (F.wave == 0) { __builtin_amdgcn_fence(__ATOMIC_ACQUIRE, "agent"); VM_WAIT(); }
        __syncthreads();
        for (int p = F.vcu; p < NT / 256; p += F.G) topk_panel(F, LOGITS, args.in[14], p, (int*)(ws + WS_IDX), (float*)(ws + WS_GATEV), (int*)(ws + WS_POSE), (int*)(ws + WS_CTL) + CW_COUNTS);
        if (BOTH(PH_RS)) xcd_barrier(bar);
    }
    if (IN(PH_SCAT)) { PHASE_PIN();
        { pg8::StaticOrder S2; S2.init(NT, DM, F.G, (int)blockIdx.x);
          pg8::Gemm g{(const bf16*)(ws + WS_SHACT), (const bf16*)(ws + WS_WSD_T), NT, DM, 256, 256, 256}; EpiShDownF E{MOD, XMB};
          pg8::gemm_phase<EpiShDownF, pg8::StaticOrder>(F.lds, g, S2, E, F.wave); }
        __syncthreads(); PHASE_PIN();
        LAS int* sc = (LAS int*)F.lds; const int* counts = (const int*)(ws + WS_CTL) + CW_COUNTS; int* misc = (int*)(ws + WS_MISC);
        const int cn = counts[F.tid]; sc[F.tid] = (cn + 255) & ~255;
        __syncthreads();
        for (int o = 1; o < 256; o <<= 1) { const int e = F.tid & 255; const int v = (e >= o) ? sc[F.tid - o] : 0; __syncthreads(); sc[F.tid] += v; __syncthreads(); }
        const int pend = sc[F.tid], pstart = pend - ((cn + 255) & ~255);
        sc[512 + F.tid] = pstart;
        if (blockIdx.x == 0) { misc[MW_PSTART + F.tid] = pstart; misc[MW_PEND + F.tid] = pend; misc[MW_CNT + F.tid] = cn; }
        sc[1024 + F.tid] = pend;
        __syncthreads();
        if (blockIdx.x == 0) { int* blke = (int*)(ws + WS_BLKE);
            for (int i = F.tid; i < NCHUNK * BLK_PER_CH; i += 512) { const int c = i / BLK_PER_CH, g = i - c * BLK_PER_CH; const int pos = 256 * g; int lo = 0, hi = NEXP;
                while (lo < hi) { const int mid = (lo + hi) >> 1; if (sc[1024 + c * NEXP + mid] > pos) hi = mid; else lo = mid + 1; }
                blke[i] = (lo < NEXP) ? lo : -1; } }
        const int* IDX = (const int*)(ws + WS_IDX); const float* GATEV = (const float*)(ws + WS_GATEV); const int* POSE = (const int*)(ws + WS_POSE);
        int* STOK = (int*)(ws + WS_STOK); float* SGATE = (float*)(ws + WS_SGATE);
        for (int i = F.vcu * 512 + F.tid; i < NT * TOPK; i += F.G * 512) { const int t = i >> 3; const int c = t / CH_TOK; const int e = IDX[i];
            const int slot = c * CH_SLOTS + sc[512 + c * NEXP + e] + POSE[i]; STOK[slot] = i; SGATE[slot] = GATEV[i]; }
        __syncthreads();
        if (BOTH(PH_SCAT)) xcd_barrier(bar);
    }
#define EXPERT_PHASE(PH, CH) if (IN(PH)) { PHASE_PIN(); \
        LAS int* mblk = (LAS int*)(F.lds + MOE_LDS_OFF); LAS int* tcode = mblk + 64; LAS float* tgate = (LAS float*)(tcode + 512); \
        if (F.tid < MOE_MAXMU) { const int g_ = F.vcu + F.tid * F.G; mblk[F.tid] = (g_ < BLK_PER_CH) ? ld_agent((const int*)(ws + WS_BLKE) + CH * BLK_PER_CH + g_) : -1; } \
        __syncthreads(); \
        MoeOrder S{CH, F.G, F.vcu, mblk, (const char*)args.out, (const char*)(ws + WS_WGU), (const char*)(ws + WS_WD), (const char*)(ws + WS_ACTS) + (size_t)blockIdx.x * 131072}; \
        EpiT1 E1{tgate, (char*)(ws + WS_ACTS) + (size_t)blockIdx.x * 131072}; EpiT2 E2{tcode, (char*)(ws + WS_YT), CH * CH_TOK * TOPK}; \
        gemm_phase_moe<EpiT1, EpiT2>(F.lds, S, E1, E2, (const int*)(ws + WS_STOK), (const float*)(ws + WS_SGATE), tcode, tgate, F.wave); \
        if (BOTH(PH)) xcd_barrier(bar); }
#define COMBINE_PHASE(PH, CH) if (IN(PH)) { PHASE_PIN(); \
        if (CH_TOK % NGW == 0 && SEQ % (CH_TOK / NGW) == 0) {     \
            const int RPW = CH_TOK / NGW, tl0 = gw * RPW, b = (CH * CH_TOK + tl0) / SEQ; f32x4 g2v[4], fgv[4]; \
            _Pragma("unroll") for (int q = 0; q < 4; ++q) { g2v[q] = *(const f32x4*)(MOD + b * 6144 + 5 * DM + 16 * F.lane + 4 * q) * (1.f / YT_SCALE); fgv[q] = *(const f32x4*)(args.in[21] + 16 * F.lane + 4 * q); } \
            for (int i = 0; i < RPW; ++i) { const int tl = tl0 + i, t = CH * CH_TOK + tl; \
                combine_row_r(XMB + (size_t)t * DM, args.out + (size_t)t * DM, (const char*)(ws + WS_YT) + (size_t)tl * TOPK * 1024, g2v, fgv, F.lane); } \
        } else \
        for (int tl = gw; tl < CH_TOK; tl += NGW) { const int t = CH * CH_TOK + tl; const int b = t / SEQ; \
            combine_row(XMB + (size_t)t * DM, args.out + (size_t)t * DM, (const char*)(ws + WS_YT) + (size_t)tl * TOPK * 1024, MOD + b * 6144 + 5 * DM, args.in[21], F.lane); } \
        if (BOTH(PH)) xcd_barrier(bar); }
    EXPERT_PHASE(PH_EXP0, 0)
    COMBINE_PHASE(PH_COMB0, 0)
#undef IN
#undef BOTH
}

static int mk_grid = 0;
static void mk_launch(void* const* d_in, void* d_out, void* d_ws, int ph_lo, int ph_hi, int li, hipStream_t stream) {
    if (mk_grid == 0) {
        int dev = 0, cus = 0, per_cu = 0;
        if (hipGetDevice(&dev) != hipSuccess || hipDeviceGetAttribute(&cus, hipDeviceAttributeMultiprocessorCount, dev) != hipSuccess) { mk_grid = -1; return; }
        if (hipFuncSetAttribute((const void*)mk_fwd, hipFuncAttributeMaxDynamicSharedMemorySize, LDS_BYTES) != hipSuccess) { mk_grid = -1; return; }
        if (hipOccupancyMaxActiveBlocksPerMultiprocessor(&per_cu, (const void*)mk_fwd, NWAVES * 64, LDS_BYTES) != hipSuccess || per_cu < 1) { fprintf(stderr, "mk_fwd: occupancy query says %d\n", per_cu); }
        (void)hipGetLastError();
        mk_grid = cus;
    }
    if (mk_grid < 0) return;
    Args a{};
    for (int i = 0; i < 22; ++i) a.in[i] = (const float*)d_in[i];
    a.out = (float*)d_out; a.ws = (unsigned char*)d_ws; a.ph_lo = ph_lo; a.ph_hi = ph_hi; a.li = li; a.pad = 0;
    hipLaunchKernelGGL(mk_fwd, dim3(mk_grid), dim3(NWAVES * 64), LDS_BYTES, stream, a);
}
extern "C" void kernel_launch(void* const* d_in, const int* in_sizes, int n_in, void* d_out, int out_size, void* d_ws, size_t ws_size, hipStream_t stream) {
    if (n_in != 22 || out_size != NT * DM || ws_size < WS_NEED) { fprintf(stderr, "kernel_launch: unexpected shapes (n_in %d out %d ws %zu)\n", n_in, out_size, ws_size); return; }
    const float* x = (const float*)d_in[0]; const float* c = (const float*)d_in[1]; const float* w_ada = (const float*)d_in[2]; const float* b_ada = (const float*)d_in[3];
    const float* norm1_g = (const float*)d_in[4]; const float* w_in = (const float*)d_in[5]; const float* b_gate = (const float*)d_in[6]; const float* qn_g = (const float*)d_in[7];
    const float* kn_g = (const float*)d_in[8]; const float* w_o_dil = (const float*)d_in[9]; const float* w_o_gqa = (const float*)d_in[10]; const float* w_out = (const float*)d_in[11];
    const float* norm2_g = (const float*)d_in[12]; const float* router_w = (const float*)d_in[13]; const float* router_bias = (const float*)d_in[14];
    const float* w_exp_gate = (const float*)d_in[15]; const float* w_exp_up = (const float*)d_in[16]; const float* w_exp_down = (const float*)d_in[17];
    const float* w_sh_gate = (const float*)d_in[18]; const float* w_sh_up = (const float*)d_in[19]; const float* w_sh_down = (const float*)d_in[20]; const float* final_g = (const float*)d_in[21];
    unsigned char* ws = (unsigned char*)d_ws; float* out = (float*)d_out;
    float* MOD = (float*)(ws + WS_MOD); float* ROPE = (float*)(ws + WS_ROPE); int* MISC = (int*)(ws + WS_MISC); int* CTL = (int*)(ws + WS_CTL);
    int* IDX = (int*)(ws + WS_IDX); float* GATEV = (float*)(ws + WS_GATEV); int* POSE = (int*)(ws + WS_POSE); int* STOK = (int*)(ws + WS_STOK); float* SGATE = (float*)(ws + WS_SGATE);
    bf16* H = (bf16*)d_out;
    bf16* QA = (bf16*)(ws + WS_QA); bf16* KA = (bf16*)(ws + WS_KA); bf16* VA = (bf16*)(ws + WS_VA); bf16* QB = (bf16*)(ws + WS_QB); bf16* KB = (bf16*)(ws + WS_KB); bf16* VB = (bf16*)(ws + WS_VB);
    bf16* GATES = (bf16*)(ws + WS_GATES); bf16* ATT = (bf16*)(ws + WS_ATT); bf16* GATED = (bf16*)(ws + WS_GATED); bf16* H2 = (bf16*)(ws + WS_H2);
    float* LOGITS = (float*)(ws + WS_LOGITS); bf16* SHACT = (bf16*)(ws + WS_SHACT); bf16* ACT = (bf16*)(ws + WS_ACT);
    float* YA = out;

    (void)hipMemsetAsync(ws + WS_CTL, 0, 1 * MiB, stream);
    (void)hipMemsetAsync(ws + WS_STOK, 0xFF, (size_t)NCHUNK * CH_SLOTS * 4, stream);
    mk_launch(d_in, d_out, d_ws, PH_PRO, PH_END, 0, stream);
}
```
